# Optimizing an MI355X kernel written in HIP

```python
import jax, jax.numpy as jnp
from jax import lax
import numpy as np

D_MODEL = 1024
BATCH = 2
SEQ = 16384
DEPTH = 4

N_HEADS = 8
HEAD_DIM = 128
D_ATTN = N_HEADS * HEAD_DIM
Q_BLOCK = 128
FORGET_BIAS = 2.0
D_RNN = D_MODEL
N_RNN_BLOCKS = 16
RNN_BLOCK = D_RNN // N_RNN_BLOCKS
CONV_WIDTH = 4
LRU_C = 8.0
D_FF = 2816
NORM_EPS = 1e-6

SPLIT_POINTS = (
    D_ATTN,
    2 * D_ATTN,
    3 * D_ATTN,
    3 * D_ATTN + N_HEADS,
    3 * D_ATTN + N_HEADS + D_RNN,
    3 * D_ATTN + N_HEADS + 2 * D_RNN,
    3 * D_ATTN + N_HEADS + 2 * D_RNN + D_MODEL,
)
N_IN = 3 * D_ATTN + N_HEADS + 2 * D_RNN + 2 * D_MODEL

kernel_name = "fox_rglru_macaron_hybrid"


def rms_norm(x, g):
    xf = x.astype(jnp.float32)
    y = xf * lax.rsqrt(jnp.mean(xf * xf, axis=-1, keepdims=True) + NORM_EPS)
    return (y * g.astype(jnp.float32)).astype(x.dtype)


def swiglu(x, w_gate, w_up, w_down):
    return (jax.nn.silu(x @ w_gate) * (x @ w_up)) @ w_down


def forgetting_attention(q, k, v, log_f):
    B, S = q.shape[0], q.shape[1]
    nb = S // Q_BLOCK
    scale = HEAD_DIM ** -0.5
    c = jnp.cumsum(log_f, axis=1).transpose(0, 2, 1)
    q = q.transpose(0, 2, 1, 3)
    k = k.transpose(0, 2, 1, 3)
    v = v.transpose(0, 2, 1, 3)
    qb = q.reshape(B, N_HEADS, nb, Q_BLOCK, HEAD_DIM).transpose(2, 0, 1, 3, 4)
    cb = c.reshape(B, N_HEADS, nb, Q_BLOCK).transpose(2, 0, 1, 3)
    k_pos = jnp.arange(S)

    def one_block(args):
        q_i, c_i, i = args
        s = jnp.einsum('bhqd,bhkd->bhqk', q_i, k).astype(jnp.float32) * scale
        s = s + (c_i[..., :, None] - c[:, :, None, :])
        q_pos = i * Q_BLOCK + jnp.arange(Q_BLOCK)
        mask = k_pos[None, :] <= q_pos[:, None]
        s = jnp.where(mask, s, -jnp.inf)
        p = jax.nn.softmax(s, axis=-1)
        return jnp.einsum('bhqk,bhkd->bhqd', p.astype(v.dtype), v)

    out = lax.map(one_block, (qb, cb, jnp.arange(nb)))
    return out.transpose(1, 0, 3, 2, 4).reshape(B, S, D_ATTN)


def causal_depthwise_conv(x, w, b):
    S = x.shape[1]
    xp = jnp.pad(x, ((0, 0), (CONV_WIDTH - 1, 0), (0, 0)))
    y = b
    for tap in range(CONV_WIDTH):
        y = y + xp[:, tap:tap + S, :] * w[tap]
    return y


def block_diag_linear(x, w, b):
    B, S = x.shape[0], x.shape[1]
    xb = x.reshape(B, S, N_RNN_BLOCKS, RNN_BLOCK)
    return jnp.einsum('bsnc,ncd->bsnd', xb, w).reshape(B, S, D_RNN) + b


def rg_lru(x, w_a, b_a, w_x, b_x, lam):
    xf = x.astype(jnp.float32)
    r = jax.nn.sigmoid(block_diag_linear(x, w_a, b_a).astype(jnp.float32))
    i = jax.nn.sigmoid(block_diag_linear(x, w_x, b_x).astype(jnp.float32))
    log_a = -LRU_C * r * jax.nn.softplus(-lam.astype(jnp.float32))
    a = jnp.exp(log_a)
    u = jnp.sqrt(-jnp.expm1(2.0 * log_a)) * (i * xf)

    def combine(left, right):
        a1, b1 = left
        a2, b2 = right
        return a1 * a2, a2 * b1 + b2

    _, h = lax.associative_scan(combine, (a, u), axis=1)
    return h.astype(x.dtype)


def setup_inputs(seed: int = 0) -> dict:
    key = jax.random.key(seed)
    ks = jax.random.split(key, 24)
    L, D, F = DEPTH, D_MODEL, D_FF
    nrm = lambda k, shape, fan_in: jax.random.normal(k, shape, jnp.float32) * (fan_in ** -0.5)
    gain = lambda k, shape: 1.0 + 0.02 * jax.random.normal(k, shape, jnp.float32)
    bias = lambda k, shape: 0.02 * jax.random.normal(k, shape, jnp.float32)

    x = jax.random.normal(ks[0], (BATCH, SEQ, D), jnp.float32)
    b_in = bias(ks[6], (L, N_IN))
    b_in = b_in.at[:, SPLIT_POINTS[2]:SPLIT_POINTS[3]].add(FORGET_BIAS)
    u = jax.random.uniform(ks[15], (L, D_RNN), jnp.float32, 0.9, 0.999)
    lru_lambda = jnp.log(u) - jnp.log1p(-u)
    return {
        "x": x,
        "ffn1_norm": gain(ks[1], (L, D)),
        "ffn1_w_gate": nrm(ks[2], (L, D, F), D),
        "ffn1_w_up": nrm(ks[3], (L, D, F), D),
        "ffn1_w_down": nrm(ks[4], (L, F, D), F),
        "mix_norm": gain(ks[5], (L, D)),
        "w_in": nrm(ks[7], (L, D, N_IN), D),
        "b_in": b_in,
        "q_norm": gain(ks[8], (L, HEAD_DIM)),
        "k_norm": gain(ks[9], (L, HEAD_DIM)),
        "conv_w": nrm(ks[10], (L, CONV_WIDTH, D_RNN), CONV_WIDTH),
        "conv_b": bias(ks[11], (L, D_RNN)),
        "lru_w_a": nrm(ks[12], (L, N_RNN_BLOCKS, RNN_BLOCK, RNN_BLOCK), RNN_BLOCK),
        "lru_b_a": bias(ks[13], (L, D_RNN)),
        "lru_w_x": nrm(ks[14], (L, N_RNN_BLOCKS, RNN_BLOCK, RNN_BLOCK), RNN_BLOCK),
        "lru_b_x": bias(ks[16], (L, D_RNN)),
        "lru_lambda": lru_lambda,
        "w_o_attn": nrm(ks[17], (L, D_ATTN, D), D_ATTN),
        "w_o_rnn": nrm(ks[18], (L, D_RNN, D), D_RNN),
        "w_out": nrm(ks[19], (L, D, D), D),
        "ffn2_norm": gain(ks[20], (L, D)),
        "ffn2_w_gate": nrm(ks[21], (L, D, F), D),
        "ffn2_w_up": nrm(ks[22], (L, D, F), D),
        "ffn2_w_down": nrm(ks[23], (L, F, D), F),
    }


def reference(x, ffn1_norm, ffn1_w_gate, ffn1_w_up, ffn1_w_down, mix_norm, w_in, b_in,
              q_norm, k_norm, conv_w, conv_b, lru_w_a, lru_b_a, lru_w_x, lru_b_x, lru_lambda,
              w_o_attn, w_o_rnn, w_out, ffn2_norm, ffn2_w_gate, ffn2_w_up, ffn2_w_down):
    B, S = x.shape[0], x.shape[1]
    for l in range(DEPTH):
        x = x + 0.5 * swiglu(rms_norm(x, ffn1_norm[l]), ffn1_w_gate[l], ffn1_w_up[l], ffn1_w_down[l])

        h = rms_norm(x, mix_norm[l])
        proj = h @ w_in[l] + b_in[l]
        q, k, v, f_logit, xr, gr, g_attn, g_rnn = jnp.split(proj, SPLIT_POINTS, axis=-1)

        q = rms_norm(q.reshape(B, S, N_HEADS, HEAD_DIM), q_norm[l])
        k = rms_norm(k.reshape(B, S, N_HEADS, HEAD_DIM), k_norm[l])
        v = v.reshape(B, S, N_HEADS, HEAD_DIM)
        log_f = jax.nn.log_sigmoid(f_logit.astype(jnp.float32))
        y_attn = forgetting_attention(q, k, v, log_f) @ w_o_attn[l]

        xr = causal_depthwise_conv(xr, conv_w[l], conv_b[l])
        yr = rg_lru(xr, lru_w_a[l], lru_b_a[l], lru_w_x[l], lru_b_x[l], lru_lambda[l]) * jax.nn.gelu(gr)
        y_rnn = yr @ w_o_rnn[l]

        merged = jax.nn.sigmoid(g_attn) * y_attn + jax.nn.sigmoid(g_rnn) * y_rnn
        x = x + merged @ w_out[l]

        x = x + 0.5 * swiglu(rms_norm(x, ffn2_norm[l]), ffn2_w_gate[l], ffn2_w_up[l], ffn2_w_down[l])
    return x
```

```cpp
#include <hip/hip_runtime.h>
#include <hip/hip_cooperative_groups.h>
#include <cstdio>
#include <cstdint>
namespace cg = cooperative_groups;

#define DEVI __device__ __forceinline__
typedef unsigned short bf16_t;
typedef short bf16x8 __attribute__((ext_vector_type(8)));
typedef short s16x4 __attribute__((ext_vector_type(4)));
typedef float f32x4 __attribute__((ext_vector_type(4)));
typedef float f32x16 __attribute__((ext_vector_type(16)));
typedef unsigned u32x4 __attribute__((ext_vector_type(4)));
typedef unsigned u32x2 __attribute__((ext_vector_type(2)));

constexpr int T_TOK = 32768, SEQ = 16384, DM = 1024, DFF = 2816, NIN = 7176, NINP = 7168, DEPTH = 4;
constexpr size_t UNIT = (size_t)T_TOK * DM * 2;
constexpr size_t WS_WIN = 8 * UNIT;
constexpr size_t WS_WOA = WS_WIN + (size_t)NINP * DM * 2;
constexpr size_t WS_WOR = WS_WOA + (size_t)DM * DM * 2;
constexpr size_t WS_WOUT = WS_WOR + (size_t)DM * DM * 2;
constexpr size_t WS_LRU = WS_WOUT + (size_t)DM * DM * 2;
constexpr size_t WS_LOGF = WS_LRU + 16 * 128 * 64 * 2;
constexpr size_t WS_CS = WS_LOGF + (size_t)T_TOK * 8 * 4;
constexpr size_t WS_JLO = WS_CS + (size_t)16 * SEQ * 4;
constexpr size_t WS_AGGA = WS_JLO + 4096;
constexpr size_t WS_AGGH = WS_AGGA + (size_t)2 * 128 * 1024 * 4;
constexpr size_t WS_CARRY = WS_AGGH + (size_t)2 * 128 * 1024 * 4;
constexpr size_t WS_BAR = WS_CARRY + (size_t)2 * 128 * 1024 * 4;
constexpr size_t WS_END = WS_BAR + 16384;
constexpr size_t FFW_GU = 4 * UNIT;
constexpr size_t FFW_D = FFW_GU + (size_t)2 * DFF * DM * 2;
constexpr int LDS_BAR = 147456;
constexpr int LDS_BYTES = LDS_BAR + 16;
#ifndef REPEAT_MASK
#define REPEAT_MASK 0x0
#endif
#ifndef SYNC_REPS
#define SYNC_REPS 1
#endif

DEVI unsigned cvtpk(float lo, float hi) { unsigned r; asm volatile("v_cvt_pk_bf16_f32 %0, %1, %2" : "=v"(r) : "v"(lo), "v"(hi)); return r; }
DEVI float bflo(unsigned w) { return __uint_as_float(w << 16); }
DEVI float bfhi(unsigned w) { return __uint_as_float(w & 0xffff0000u); }
DEVI float sigmoidf_(float x) { return __builtin_amdgcn_rcpf(1.f + __expf(-x)); }
DEVI int ltid(int wv) { int t = (wv << 6) | (int)__builtin_amdgcn_mbcnt_hi(~0u, __builtin_amdgcn_mbcnt_lo(~0u, 0u)); asm volatile("" : "+v"(t)); return t; }
DEVI int lbid() { int t = blockIdx.x; asm volatile("" : "+s"(t)); return t; }
DEVI int lgrid() { int t = gridDim.x; asm volatile("" : "+s"(t)); return t; }
template <int CTRL> DEVI float dpp(float x) { return __builtin_bit_cast(float, __builtin_amdgcn_mov_dpp(__builtin_bit_cast(int, x), CTRL, 0xf, 0xf, true)); }
template <int CTRL> DEVI unsigned dppu(unsigned x) { return (unsigned)__builtin_amdgcn_mov_dpp((int)x, CTRL, 0xf, 0xf, true); }
DEVI float xrow16_sum(float x) {
    auto s = __builtin_amdgcn_permlane16_swap(__float_as_uint(x), __float_as_uint(x), false, false);
    x = __uint_as_float(s[0]) + __uint_as_float(s[1]);
    auto t = __builtin_amdgcn_permlane32_swap(__float_as_uint(x), __float_as_uint(x), false, false);
    return __uint_as_float(t[0]) + __uint_as_float(t[1]);
}
DEVI float xrow16_max(float x) {
    auto s = __builtin_amdgcn_permlane16_swap(__float_as_uint(x), __float_as_uint(x), false, false);
    x = fmaxf(__uint_as_float(s[0]), __uint_as_float(s[1]));
    auto t = __builtin_amdgcn_permlane32_swap(__float_as_uint(x), __float_as_uint(x), false, false);
    return fmaxf(__uint_as_float(t[0]), __uint_as_float(t[1]));
}
DEVI float wave_sum(float v) { v += dpp<0xB1>(v); v += dpp<0x4E>(v); v += dpp<0x124>(v); v += dpp<0x128>(v); return xrow16_sum(v); }
DEVI float wave_max(float v) { v = fmaxf(v, dpp<0xB1>(v)); v = fmaxf(v, dpp<0x4E>(v)); v = fmaxf(v, dpp<0x124>(v)); v = fmaxf(v, dpp<0x128>(v)); return xrow16_max(v); }


#define XB_TMO      128
#define XB_XCNT(j)  (256  + 64 * (j))
#define XB_XSUB(j)  (1280 + 64 * (j))
#define XB_XGEN(j)  (2304 + 64 * (j))
#define XB_TOP      3328
#define XB_TOPGEN   3392
#define XCD_BAR_WORDS 3456
#define XB_SPIN_CAP (1u << 20)
#define LAS __attribute__((address_space(3)))
DEVI unsigned xb_ld(unsigned* p)              { return __hip_atomic_load(p, __ATOMIC_RELAXED, __HIP_MEMORY_SCOPE_AGENT); }
DEVI unsigned xb_add(unsigned* p, unsigned v) { return __hip_atomic_fetch_add(p, v, __ATOMIC_RELAXED, __HIP_MEMORY_SCOPE_AGENT); }
DEVI unsigned xb_xcc_id() { return (unsigned)__builtin_amdgcn_s_getreg((3 << 11) | 20) & 0xFu; }
#define XB_SPIN(cond, bar) do { unsigned _sp = 0; while (cond) { __builtin_amdgcn_s_sleep(1); \
    if ((++_sp & 255u) == 0u) { if (xb_ld(&(bar)[XB_TMO])) break; if (_sp > XB_SPIN_CAP) { atomicAdd(&(bar)[XB_TMO], 1u); break; } } } } while (0)
struct XcdBarrier { unsigned* bar; unsigned x; volatile LAS unsigned* st; };
DEVI XcdBarrier xcd_barrier_post(unsigned* bar, volatile LAS unsigned* st, int wv) {
    XcdBarrier b; b.bar = bar; b.x = xb_xcc_id(); b.st = st;
    if (ltid(wv) == 0) (void)xb_add(&bar[XB_XCNT(b.x)], 1u);
    return b;
}
DEVI void xcd_barrier_complete(unsigned* bar, unsigned x, unsigned& nloc, unsigned& nx) {
    const unsigned G = gridDim.x * gridDim.y * gridDim.z;
    unsigned sum, cnt, mine, sp = 0u;
    for (;;) {
        sum = 0u; cnt = 0u; mine = 0u;
#pragma unroll
        for (unsigned j = 0; j < 16; ++j) { const unsigned c = xb_ld(&bar[XB_XCNT(j)]); sum += c; cnt += (c > 0u) ? 1u : 0u; mine = (j == x) ? c : mine; }
        if (sum == G) break;
        __builtin_amdgcn_s_sleep(1);
        if ((++sp & 255u) == 0u) { if (xb_ld(&bar[XB_TMO])) break; if (sp > XB_SPIN_CAP) { atomicAdd(&bar[XB_TMO], 1u); break; } }
    }
    nloc = mine > 0u ? mine : 1u; nx = cnt > 0u ? cnt : 1u;
}
DEVI void xcd_barrier(const XcdBarrier& b, int wv) {
    asm volatile("s_waitcnt vmcnt(0)" ::: "memory");
    __syncthreads();
    if (ltid(wv) == 0) {
        unsigned* bar = b.bar;
        __builtin_amdgcn_s_waitcnt(0);
        unsigned nloc = b.st[0], nx = b.st[1];
        if (nloc == 0u) { xcd_barrier_complete(bar, b.x, nloc, nx); b.st[0] = nloc; b.st[1] = nx; }
        const unsigned old = xb_add(&bar[XB_XSUB(b.x)], 1u);
        const unsigned gen = old / nloc;
        if (old + 1u == (gen + 1u) * nloc) {
            __builtin_amdgcn_fence(__ATOMIC_RELEASE, "agent");
            asm volatile("s_waitcnt vmcnt(0)" ::: "memory");
            const unsigned og = xb_add(&bar[XB_TOP], 1u);
            const unsigned tg = og / nx;
            if (og + 1u == (tg + 1u) * nx) xb_add(&bar[XB_TOPGEN], 1u);
            else XB_SPIN(xb_ld(&bar[XB_TOPGEN]) == tg, bar);
            __builtin_amdgcn_fence(__ATOMIC_ACQUIRE, "agent");
            xb_add(&bar[XB_XGEN(b.x)], 1u);
            asm volatile("s_waitcnt vmcnt(0)" ::: "memory");
        } else {
            XB_SPIN(xb_ld(&bar[XB_XGEN(b.x)]) == gen, bar);
            __builtin_amdgcn_fence(__ATOMIC_ACQUIRE, "agent");
            asm volatile("s_waitcnt vmcnt(0)" ::: "memory");
        }
    }
    __syncthreads();
}

namespace pg8 {
#define PG8_LAS __attribute__((address_space(3)))
constexpr int BM = 256, BK = 64, HALF = 128, HTB = HALF * BK * 2, STAGE_BYTES = 8 * HTB, NXCD = 8, WGM = 8;
__host__ __device__ __forceinline__ int lds_byte(int r, int c) { const int st = (r >> 4) * 2 + (c >> 5), rr = r & 15, cc = c & 31, ob = rr * 64 + cc * 2; return st * 1024 + (ob ^ (((ob >> 9) & 1) << 5)); }
__host__ __device__ __forceinline__ void stage_rc(int b, int& R, int& C) { const int st = b / 1024, sb = b % 1024, swz = sb ^ (((sb >> 9) & 1) << 5); R = (st >> 1) * 16 + swz / 64; C = (st & 1) * 32 + (swz % 64) / 2; }
struct Unit { int pm, pn; };
__host__ __device__ __forceinline__ int perm32(int rho) { const int n = rho >> 4, i = rho & 15; return 8 * (i >> 2) + 4 * n + (i & 3); }
struct Gemm { const bf16_t* A; const bf16_t* Bt; int M, N, K; const bf16_t* A2; int lda; };
struct StaticOrder {
    int nM, nN, nwg, G, c;
    __device__ void init(int M, int N, int G_, int c_) { nM = M / BM; nN = N / BM; nwg = nM * nN; G = G_; c = c_; }
    __device__ bool next(int i, Unit& u) const {
        const long L = (long)i * G + c; if (L >= nwg) return false;
        int wgid = (int)L; { const int q = nwg / NXCD, r = nwg % NXCD, xcd = wgid % NXCD, off = wgid / NXCD; wgid = (xcd < r ? xcd * (q + 1) : r * (q + 1) + (xcd - r) * q) + off; }
        const int nig = WGM * nN, gid = wgid / nig, fm = gid * WGM, gsz = (nM - fm) < WGM ? (nM - fm) : WGM;
        u.pm = fm + ((wgid % nig) % gsz); u.pn = (wgid % nig) / gsz; return true;
    }
};
template <class Epi, class Sched>
__device__ __forceinline__ void gemm_phase(PG8_LAS unsigned char* lds, const Gemm g, const Sched& S, const Epi& E, int wv) {
    const int tid = ltid(wv), wid = __builtin_amdgcn_readfirstlane(tid >> 6), lane = tid & 63, wr = wid >> 2, wc = wid & 3, fr = lane & 15, fq = lane >> 4;
    const int K = g.K, nt = K / BK;
    unsigned voffA[2], voffB[2];
    const int lda = g.lda;
#pragma unroll
    for (int i = 0; i < 2; ++i) { int R, C; stage_rc(tid * 16 + i * 8192, R, C); const int Rb = Epi::ADJ ? (64 * (R >> 5) + perm32(R & 31)) : (Epi::PERM ? ((R & ~31) + perm32(R & 31)) : R);
        voffA[i] = (unsigned)(R * lda + C) * 2u; voffB[i] = (unsigned)(Rb * K + C) * 2u; }
    const size_t kstep = (size_t)(BK * 2);
    const size_t hstepA = (size_t)HALF * lda * 2, hstep = (size_t)HALF * K * 2;
    const size_t tstepA = 2 * hstepA, tstep = 2 * hstep;
    const size_t hb = Epi::ADJ ? (size_t)32 * K * 2 : hstep;
    constexpr bool SPLIT = Epi::SPLIT;
    const int ksp = nt >> 1;
    const unsigned ldsw = (unsigned)wid * 1024u;
    const int aoff = lds_byte(wr * 64 + fr, fq * 8), boff = lds_byte(wc * 32 + fr, fq * 8);
#define PG8_SA(b, h) (((b) * 2 + (h)) * HTB)
#define PG8_SB(b, h) ((4 + (b) * 2 + (h)) * HTB)
#define PG8_STAGE(bufoff, gbase, voff) do { _Pragma("unroll") for (int _i = 0; _i < 2; ++_i) \
        __builtin_amdgcn_global_load_lds((const unsigned*)((const char*)(gbase) + (voff)[_i]), (PG8_LAS unsigned*)(lds + (bufoff) + ldsw + _i * 8192), 16, 0, 0); } while (0)
#define PG8_LDA(dst, b, h) do { _Pragma("unroll") for (int m = 0; m < 4; ++m) _Pragma("unroll") for (int k = 0; k < 2; ++k) dst[m][k] = *(const PG8_LAS bf16x8*)(lds + PG8_SA(b, h) + aoff + m * 2048 + k * 1024); } while (0)
#define PG8_LDB(dst, b, h) do { _Pragma("unroll") for (int n = 0; n < 2; ++n) _Pragma("unroll") for (int k = 0; k < 2; ++k) dst[n][k] = *(const PG8_LAS bf16x8*)(lds + PG8_SB(b, h) + boff + n * 2048 + k * 1024); } while (0)
#define PG8_MMA(ai, bj, At, Bt) do { __builtin_amdgcn_s_setprio(1); _Pragma("unroll") for (int m = 0; m < 4; ++m) _Pragma("unroll") for (int n = 0; n < 2; ++n) _Pragma("unroll") for (int k = 0; k < 2; ++k) \
        acc[ai][bj][m][n] = __builtin_amdgcn_mfma_f32_16x16x32_bf16(Bt[n][k], At[m][k], acc[ai][bj][m][n], 0, 0, 0); __builtin_amdgcn_s_setprio(0); } while (0)
#define PG8_WAIT_V(n) asm volatile("s_waitcnt vmcnt(" #n ")" ::: "memory")
#define PG8_WAIT_L(n) asm volatile("s_waitcnt lgkmcnt(" #n ")" ::: "memory")
#define PG8_BAR __builtin_amdgcn_s_barrier()
#define PG8_SCHED __builtin_amdgcn_sched_barrier(0)
    Unit cur, nxt; int ui = 0;
    if (!S.next(0, cur)) return;
    f32x4 acc[2][2][4][2];
#pragma unroll
    for (int a = 0; a < 2; ++a)
#pragma unroll
        for (int b = 0; b < 2; ++b)
#pragma unroll
            for (int m = 0; m < 4; ++m)
#pragma unroll
                for (int n = 0; n < 2; ++n) acc[a][b][m][n] = (f32x4){0.f, 0.f, 0.f, 0.f};
    bf16x8 At[4][2], B0[2][2], B1[2][2];
    const char* cA = (const char*)g.A + (size_t)cur.pm * tstepA; const char* cB = (const char*)g.Bt + (size_t)cur.pn * tstep;
    const long dA2 = SPLIT ? ((const char*)g.A2 - (const char*)g.A) - (long)ksp * (long)kstep : 0l;
    PG8_STAGE(PG8_SB(0, 0), cB, voffB); PG8_STAGE(PG8_SA(0, 0), cA, voffA); PG8_STAGE(PG8_SB(0, 1), cB + hb, voffB); PG8_STAGE(PG8_SA(0, 1), cA + hstepA, voffA);
    if (wr == 1) PG8_BAR;
    PG8_WAIT_V(4); PG8_BAR;
    PG8_STAGE(PG8_SB(1, 0), cB + kstep, voffB); PG8_STAGE(PG8_SA(1, 0), cA + kstep, voffA); PG8_STAGE(PG8_SB(1, 1), cB + hb + kstep, voffB);
    PG8_WAIT_V(6); PG8_BAR;
    for (;;) {
        const bool has_next = S.next(ui + 1, nxt);
        const char* nA = has_next ? (const char*)g.A + (size_t)nxt.pm * tstepA : cA; const char* nB = has_next ? (const char*)g.Bt + (size_t)nxt.pn * tstep : cB;
        for (int t = 0; t < nt; t += 2) {
            const bool last = (t == nt - 2);
            if constexpr (Epi::MID) { if (t == ksp) E.mid(acc, cur, wr, wc, fr, fq); }
            const char* a1 = cA + (size_t)(t + 1) * kstep + ((SPLIT && t >= ksp) ? dA2 : 0l);
            const char* a2 = last ? nA : cA + (size_t)(t + 2) * kstep + ((SPLIT && t + 2 >= ksp) ? dA2 : 0l); const char* b2 = last ? nB : cB + (size_t)(t + 2) * kstep;
            const char* a3 = a2 + kstep; const char* b3 = b2 + kstep;
            PG8_LDB(B0, 0, 0); PG8_SCHED; PG8_LDA(At, 0, 0); PG8_STAGE(PG8_SA(1, 1), a1 + hstepA, voffA);
            PG8_WAIT_L(8); PG8_BAR; PG8_WAIT_L(0); PG8_MMA(0, 0, At, B0); PG8_BAR; PG8_SCHED;
            PG8_LDB(B1, 0, 1); PG8_STAGE(PG8_SB(0, 0), b2, voffB);
            PG8_BAR; PG8_WAIT_L(0); PG8_MMA(0, 1, At, B1); PG8_BAR;
            PG8_LDA(At, 0, 1); PG8_STAGE(PG8_SA(0, 0), a2, voffA);
            PG8_BAR; PG8_WAIT_L(0); PG8_MMA(1, 0, At, B0); PG8_BAR; PG8_SCHED;
            PG8_STAGE(PG8_SB(0, 1), b2 + hb, voffB);
            PG8_WAIT_V(6); PG8_BAR; PG8_MMA(1, 1, At, B1); PG8_BAR;
            PG8_LDB(B0, 1, 0); PG8_SCHED; PG8_LDA(At, 1, 0); PG8_STAGE(PG8_SA(0, 1), a2 + hstepA, voffA);
            PG8_WAIT_L(8); PG8_BAR; PG8_WAIT_L(0); PG8_MMA(0, 0, At, B0); PG8_BAR; PG8_SCHED;
            PG8_LDB(B1, 1, 1); PG8_STAGE(PG8_SB(1, 0), b3, voffB);
            PG8_BAR; PG8_WAIT_L(0); PG8_MMA(0, 1, At, B1); PG8_BAR;
            PG8_LDA(At, 1, 1); PG8_STAGE(PG8_SA(1, 0), a3, voffA);
            PG8_BAR; PG8_WAIT_L(0); PG8_MMA(1, 0, At, B0); PG8_BAR; PG8_SCHED;
            PG8_STAGE(PG8_SB(1, 1), b3 + hb, voffB);
            PG8_WAIT_V(6); PG8_BAR; PG8_MMA(1, 1, At, B1); PG8_BAR;
        }
        E(acc, cur, wr, wc, fr, fq);
        if (!has_next) break;
#pragma unroll
        for (int a = 0; a < 2; ++a)
#pragma unroll
            for (int b = 0; b < 2; ++b)
#pragma unroll
                for (int m = 0; m < 4; ++m)
#pragma unroll
                    for (int n = 0; n < 2; ++n) acc[a][b][m][n] = (f32x4){0.f, 0.f, 0.f, 0.f};
        cur = nxt; cA = nA; cB = nB; ++ui;
    }
    PG8_WAIT_V(0);
    if (wr == 0) PG8_BAR;
    PG8_BAR;
#undef PG8_SA
#undef PG8_SB
#undef PG8_STAGE
#undef PG8_LDA
#undef PG8_LDB
#undef PG8_MMA
#undef PG8_WAIT_V
#undef PG8_WAIT_L
#undef PG8_BAR
#undef PG8_SCHED
}
}

typedef f32x4 (&AccRef)[2][2][4][2];

struct EpiUp {
    static constexpr bool PERM = true, SPLIT = false, MID = false, ADJ = false;
    bf16_t* Hm;
    DEVI void operator()(AccRef acc, const pg8::Unit& u, int wr, int wc, int fr, int fq) const {
        const int row0 = u.pm * 256 + wr * 64 + fr, col = u.pn * 128 + wc * 32 + 8 * fq;
#pragma unroll
        for (int ai = 0; ai < 2; ++ai)
#pragma unroll
            for (int m = 0; m < 4; ++m) { bf16_t* rowp = Hm + (size_t)(row0 + ai * 128 + m * 16) * DFF + col; float h[8];
#pragma unroll
                for (int j = 0; j < 8; ++j) { const float gt = acc[ai][0][m][j >> 2][j & 3], up = acc[ai][1][m][j >> 2][j & 3]; h[j] = gt * sigmoidf_(gt) * up; }
                u32x4 w; w.x = cvtpk(h[0], h[1]); w.y = cvtpk(h[2], h[3]); w.z = cvtpk(h[4], h[5]); w.w = cvtpk(h[6], h[7]); __builtin_nontemporal_store(w, (u32x4*)rowp); }
    }
};
struct EpiRes {
    static constexpr bool PERM = false, SPLIT = false, MID = false, ADJ = false;
    const float* base; float* out; float alpha;
    DEVI void operator()(AccRef acc, const pg8::Unit& u, int wr, int wc, int fr, int fq) const {
        unsigned o = (unsigned)((u.pm * 256 + wr * 64 + fr) * DM + u.pn * 256 + wc * 32 + 4 * fq) * 4u;
        const bool lo = fr < 8;
        unsigned os = (unsigned)((u.pm * 256 + wr * 64 + (fr & 7)) * DM + u.pn * 256 + wc * 32 + 4 * fq) * 4u + (lo ? 0u : 64u);
#pragma unroll
        for (int ai = 0; ai < 2; ++ai) {
            asm volatile("" : "+v"(o), "+v"(os));
            f32x4 b[4][2][2];
#pragma unroll
            for (int m = 0; m < 4; ++m)
#pragma unroll
                for (int bj = 0; bj < 2; ++bj)
#pragma unroll
                    for (int n = 0; n < 2; ++n) b[m][bj][n] = *(const f32x4*)((const char*)base + o + (unsigned)(m * 16 * DM * 4 + bj * 512 + n * 64));
#pragma unroll
            for (int m = 0; m < 4; ++m)
#pragma unroll
                for (int bj = 0; bj < 2; ++bj) { const f32x4 d0 = b[m][bj][0] + alpha * acc[ai][bj][m][0], d1 = b[m][bj][1] + alpha * acc[ai][bj][m][1];
                    f32x4 t0, t1;
#pragma unroll
                    for (int i = 0; i < 4; ++i) { t0[i] = dpp<0x128>(d0[i]); t1[i] = dpp<0x128>(d1[i]); }
                    const f32x4 sa = lo ? d0 : t1, sb = lo ? t0 : d1;
                    const unsigned oo = os + (unsigned)(m * 16 * DM * 4 + bj * 512);
                    *(f32x4*)((char*)out + oo) = sa; *(f32x4*)((char*)out + oo + 8u * DM * 4u) = sb; }
            o += 128u * DM * 4u; os += 128u * DM * 4u; }
    }
};
struct EpiInProj {
    static constexpr bool PERM = true, SPLIT = false, MID = false, ADJ = true;
    unsigned char* ws; const float* bias; const float* qg; const float* kg; float* Pt;
    DEVI void operator()(AccRef acc, const pg8::Unit& u, int wr, int wc, int fr, int fq) const {
        const int sel = u.pn >> 2; bf16_t* dst = (bf16_t*)(ws + (size_t)(sel + 1) * UNIT);
        const int tcol = wc * 64 + 8 * fq, bcol0 = u.pn * 256 + tcol + (u.pn >= 12 ? 8 : 0);
#pragma unroll
        for (int bj = 0; bj < 2; ++bj)
#pragma unroll
            for (int n = 0; n < 2; ++n) { const f32x4 bv = *(const f32x4*)(bias + bcol0 + bj * 32 + n * 4);
#pragma unroll
                for (int ai = 0; ai < 2; ++ai)
#pragma unroll
                    for (int m = 0; m < 4; ++m) acc[ai][bj][m][n] += bv; }
        if (u.pn < 8) {
#pragma unroll
            for (int ai = 0; ai < 2; ++ai)
#pragma unroll
                for (int m = 0; m < 4; ++m) { float s = 0.f;
#pragma unroll
                    for (int bj = 0; bj < 2; ++bj) { const f32x4 a = acc[ai][bj][m][0], b = acc[ai][bj][m][1];
                        s += (a[0] * a[0] + a[1] * a[1]) + (a[2] * a[2] + a[3] * a[3]) + (b[0] * b[0] + b[1] * b[1]) + (b[2] * b[2] + b[3] * b[3]); }
                    s = xrow16_sum(s);
                    if (fq == 0) Pt[(ai * 128 + wr * 64 + m * 16 + fr) * 4 + wc] = s; }
            asm volatile("s_waitcnt lgkmcnt(0)" ::: "memory"); __builtin_amdgcn_s_barrier(); asm volatile("" ::: "memory");
            const float* gsrc = (u.pn < 4 ? qg : kg) + (wc & 1) * 64 + 8 * fq;
            const f32x4 g00 = *(const f32x4*)gsrc, g01 = *(const f32x4*)(gsrc + 4), g10 = *(const f32x4*)(gsrc + 32), g11 = *(const f32x4*)(gsrc + 36);
#pragma unroll
            for (int ai = 0; ai < 2; ++ai)
#pragma unroll
                for (int m = 0; m < 4; ++m) { const float* pp = Pt + (ai * 128 + wr * 64 + m * 16 + fr) * 4 + (wc & 2);
                    const float rstd = __builtin_amdgcn_rsqf((pp[0] + pp[1]) * (1.f / 128.f) + 1e-6f);
                    acc[ai][0][m][0] *= g00 * rstd; acc[ai][0][m][1] *= g01 * rstd; acc[ai][1][m][0] *= g10 * rstd; acc[ai][1][m][1] *= g11 * rstd; }
        }
        const bool lo = fr < 8;
        bf16_t* sp = dst + (size_t)(u.pm * 256 + wr * 64 + (fr & 7)) * DM + (u.pn & 3) * 256 + tcol + (lo ? 0 : 32);
#pragma unroll
        for (int ai = 0; ai < 2; ++ai)
#pragma unroll
            for (int m = 0; m < 4; ++m) { bf16_t* rowp = sp + (size_t)(ai * 128 + m * 16) * DM;
                const f32x4 a0 = acc[ai][0][m][0], a1 = acc[ai][0][m][1], b0 = acc[ai][1][m][0], b1 = acc[ai][1][m][1];
                const u32x4 w0 = {cvtpk(a0[0], a0[1]), cvtpk(a0[2], a0[3]), cvtpk(a1[0], a1[1]), cvtpk(a1[2], a1[3])}, w1 = {cvtpk(b0[0], b0[1]), cvtpk(b0[2], b0[3]), cvtpk(b1[0], b1[1]), cvtpk(b1[2], b1[3])};
                u32x4 t0, t1;
#pragma unroll
                for (int i = 0; i < 4; ++i) { t0[i] = dppu<0x128>(w0[i]); t1[i] = dppu<0x128>(w1[i]); }
                const u32x4 sa = lo ? w0 : t1, sb = lo ? t0 : w1;
                __builtin_nontemporal_store(sa, (u32x4*)rowp); __builtin_nontemporal_store(sb, (u32x4*)(rowp + 8 * DM)); }
    }
};
struct EpiMergeF {
    static constexpr bool PERM = true, SPLIT = true, MID = true, ADJ = false;
    const bf16_t* gA; const bf16_t* gR; bf16_t* out;
    DEVI void mid(AccRef acc, const pg8::Unit& u, int wr, int wc, int fr, int fq) const {
        unsigned o = (unsigned)((u.pm * 256 + wr * 64 + fr) * DM + u.pn * 256 + wc * 32 + 8 * fq) * 2u;
#pragma unroll
        for (int ai = 0; ai < 2; ++ai) {
            asm volatile("" : "+v"(o));
            u32x4 ga[4][2], gr[4][2];
#pragma unroll
            for (int m = 0; m < 4; ++m)
#pragma unroll
                for (int bj = 0; bj < 2; ++bj) { ga[m][bj] = *(const u32x4*)((const char*)gA + o + (unsigned)(m * 16 * DM * 2 + bj * 256)); gr[m][bj] = *(const u32x4*)((const char*)gR + o + (unsigned)(m * 16 * DM * 2 + bj * 256)); }
#pragma unroll
            for (int m = 0; m < 4; ++m)
#pragma unroll
                for (int bj = 0; bj < 2; ++bj) { const u32x4 a = ga[m][bj], r = gr[m][bj];
                    const float av[8] = {bflo(a.x), bfhi(a.x), bflo(a.y), bfhi(a.y), bflo(a.z), bfhi(a.z), bflo(a.w), bfhi(a.w)};
                    const float rv[8] = {bflo(r.x), bfhi(r.x), bflo(r.y), bfhi(r.y), bflo(r.z), bfhi(r.z), bflo(r.w), bfhi(r.w)};
#pragma unroll
                    for (int j = 0; j < 8; ++j) { const float q = (1.f + __expf(-rv[j])) * __builtin_amdgcn_rcpf(1.f + __expf(-av[j])); acc[ai][bj][m][j >> 2][j & 3] *= q; } }
            o += 128u * DM * 2u; }
    }
    DEVI void operator()(AccRef acc, const pg8::Unit& u, int wr, int wc, int fr, int fq) const {
        unsigned o = (unsigned)((u.pm * 256 + wr * 64 + fr) * DM + u.pn * 256 + wc * 32 + 8 * fq) * 2u;
#pragma unroll
        for (int ai = 0; ai < 2; ++ai) {
            asm volatile("" : "+v"(o));
            u32x4 gr[4][2];
#pragma unroll
            for (int m = 0; m < 4; ++m)
#pragma unroll
                for (int bj = 0; bj < 2; ++bj) gr[m][bj] = *(const u32x4*)((const char*)gR + o + (unsigned)(m * 16 * DM * 2 + bj * 256));
#pragma unroll
            for (int m = 0; m < 4; ++m)
#pragma unroll
                for (int bj = 0; bj < 2; ++bj) { const u32x4 r = gr[m][bj];
                    const float rv[8] = {bflo(r.x), bfhi(r.x), bflo(r.y), bfhi(r.y), bflo(r.z), bfhi(r.z), bflo(r.w), bfhi(r.w)}; float v[8];
#pragma unroll
                    for (int j = 0; j < 8; ++j) v[j] = acc[ai][bj][m][j >> 2][j & 3] * sigmoidf_(rv[j]);
                    u32x4 w; w.x = cvtpk(v[0], v[1]); w.y = cvtpk(v[2], v[3]); w.z = cvtpk(v[4], v[5]); w.w = cvtpk(v[6], v[7]); *(u32x4*)((char*)out + o + (unsigned)(m * 16 * DM * 2 + bj * 256)) = w; }
            o += 128u * DM * 2u; }
    }
};

namespace att {
constexpr float SCALE = 0.08838834764831845f;
constexpr int NW = 8, QBLK = 32, KVBLK = 64, QB = NW * QBLK, D = 128, RS = 1024;
constexpr int SHM_V = KVBLK * D * 2, SHM_K = KVBLK * D * 2;
constexpr int OFF_WS = 2 * SHM_V + 2 * SHM_K, OFF_BIAS = OFF_WS + NW * 64 * 4;
constexpr float THR = 8.f;
constexpr unsigned WBIG = 0x40000000u;
#define KSWZ(row, colB) ((row) * 256 + ((colB) ^ (((row) & 7) << 4)))
#define SBAR() __builtin_amdgcn_sched_barrier(0)
DEVI int v_st(int k, int c) { const int kk = (k & ~0xC) | ((k & 4) << 1) | ((k & 8) >> 1); return ((kk >> 3) * 4 + (c >> 5)) * 512 + ((kk & 7) * 32 + (c & 31)) * 2; }
DEVI int v_rd_base(int lane) { return ((lane & 3) << 3) | (((lane >> 2) & 3) << 6) | (((lane >> 4) & 1) << 5) | (((lane >> 5) & 1) << 8); }
constexpr int v_rd_off(int d0, int ks, int half) { return d0 * 512 + ks * 4096 + half * 2048; }
DEVI int crow(int r, int hi) { return (r & 3) + 8 * (r >> 2) + 4 * hi; }
DEVI bf16x8 ld8(const bf16_t* p) { return *reinterpret_cast<const bf16x8*>(p); }
DEVI void mask_tile(f32x16& p0, f32x16& p1, int dq, unsigned W) {
    const float NEG = -__builtin_inff();
#pragma unroll
    for (int r = 0; r < 16; ++r) {
        const int c = (r & 3) + 8 * (r >> 2);
        if ((unsigned)(dq - c) >= W) p0[r] = NEG;
        if ((unsigned)(dq - c - 32) >= W) p1[r] = NEG;
    }
}
DEVI void partialSM(f32x16& p0, f32x16& p1, float& m_reg, float& mn, float& alpha) {
    float pmax = p0[0]; for (int r = 1; r < 16; ++r) pmax = fmaxf(pmax, p0[r]); for (int r = 0; r < 16; ++r) pmax = fmaxf(pmax, p1[r]);
    { auto rr = __builtin_amdgcn_permlane32_swap(__float_as_uint(pmax), __float_as_uint(pmax), false, false);
      pmax = fmaxf(__uint_as_float(rr[0]), __uint_as_float(rr[1])); }
    constexpr float C2 = 1.4426950408889634f * SCALE;
    if (__builtin_expect(__all((pmax - m_reg) * SCALE <= THR), 1)) { mn = m_reg; alpha = 1.f; }
    else { mn = fmaxf(m_reg, pmax); alpha = __builtin_amdgcn_exp2f((m_reg - mn) * C2); m_reg = mn; }
    const float mnL = -mn * C2;
    for (int r = 0; r < 16; ++r) p0[r] = fmaf(p0[r], C2, mnL); for (int r = 0; r < 16; ++r) p1[r] = fmaf(p1[r], C2, mnL);
    for (int r = 0; r < 16; ++r) p0[r] = __builtin_amdgcn_exp2f(p0[r]);
}
DEVI void finishSM(f32x16& p0, f32x16& p1, float alpha, float& l_reg, bf16x8& pa0, bf16x8& pa1, bf16x8& pa2, bf16x8& pa3) {
    for (int r = 0; r < 16; ++r) p1[r] = __builtin_amdgcn_exp2f(p1[r]);
    float ps = 0; for (int r = 0; r < 16; ++r) ps += p0[r]; for (int r = 0; r < 16; ++r) ps += p1[r];
    { auto rr = __builtin_amdgcn_permlane32_swap(__float_as_uint(ps), __float_as_uint(ps), false, false);
      ps = __uint_as_float(rr[0]) + __uint_as_float(rr[1]); }
    l_reg = l_reg * alpha + ps;
#define PK4(P, B_, OUT) do { unsigned a0 = cvtpk(P[B_+0], P[B_+1]), a1 = cvtpk(P[B_+2], P[B_+3]);                          \
        unsigned b0 = cvtpk(P[B_+4], P[B_+5]), b1 = cvtpk(P[B_+6], P[B_+7]);                                             \
        auto r0 = __builtin_amdgcn_permlane32_swap(a0, b0, false, false); auto r1 = __builtin_amdgcn_permlane32_swap(a1, b1, false, false); \
        u32x4 w = {r0[0], r1[0], r0[1], r1[1]}; OUT = *reinterpret_cast<bf16x8*>(&w); } while (0)
    PK4(p0, 0, pa0); PK4(p0, 8, pa1); PK4(p1, 0, pa2); PK4(p1, 8, pa3);
#undef PK4
}
template <int KB>
DEVI void qkt(f32x16& p0, f32x16& p1, const char* K_lds, const char* biasb0, int r32, int hi, const bf16x8* qr) {
    int hb_ = hi * 16; asm volatile("" : "+v"(hb_)); const char* biasb = biasb0 + hb_;
#pragma unroll
    for (int g = 0; g < 4; ++g) { const f32x4 b0 = *(const f32x4*)(biasb + KB * 256 + g * 32), b1 = *(const f32x4*)(biasb + KB * 256 + 128 + g * 32);
#pragma unroll
        for (int i = 0; i < 4; ++i) { p0[4 * g + i] = b0[i]; p1[4 * g + i] = b1[i]; } }
    const char* kb[4];
#pragma unroll
    for (int dd = 0; dd < 4; ++dd) kb[dd] = K_lds + KB * SHM_K + KSWZ(r32, (dd * 16 + hi * 8) * 2);
#pragma unroll
    for (int d0 = 0; d0 < 8; ++d0) { const char* a = kb[d0 & 3] + (d0 >> 2) * 128;
        bf16x8 b0 = *reinterpret_cast<const bf16x8*>(a);
        bf16x8 b1 = *reinterpret_cast<const bf16x8*>(a + 32 * 256);
        p0 = __builtin_amdgcn_mfma_f32_32x32x16_bf16(b0, qr[d0], p0, 0, 0, 0);
        p1 = __builtin_amdgcn_mfma_f32_32x32x16_bf16(b1, qr[d0], p1, 0, 0, 0); }
}
template <int VB>
DEVI void pv_tile(f32x16* o, int vb0, bf16x8 pa0, bf16x8 pa1, bf16x8 pa2, bf16x8 pa3) {
#define TRRD(dst, off) asm volatile("ds_read_b64_tr_b16 %0, %1 offset:%2" : "=&v"(dst) : "v"(vb0), "i"(off) : "memory")
#define PV_D0(d0) do { s16x4 l0, l1, l2, l3, h0, h1, h2, h3; constexpr int b_ = VB * SHM_V + v_rd_off(d0, 0, 0); \
        TRRD(l0, b_); TRRD(h0, b_ + 2048); TRRD(l1, b_ + 4096); TRRD(h1, b_ + 6144); TRRD(l2, b_ + 8192); TRRD(h2, b_ + 10240); TRRD(l3, b_ + 12288); TRRD(h3, b_ + 14336); \
        asm volatile("s_waitcnt lgkmcnt(0)" ::: "memory"); SBAR();   \
        o[d0] = __builtin_amdgcn_mfma_f32_32x32x16_bf16(pa0, (bf16x8){l0[0], l0[1], l0[2], l0[3], h0[0], h0[1], h0[2], h0[3]}, o[d0], 0, 0, 0);   \
        o[d0] = __builtin_amdgcn_mfma_f32_32x32x16_bf16(pa1, (bf16x8){l1[0], l1[1], l1[2], l1[3], h1[0], h1[1], h1[2], h1[3]}, o[d0], 0, 0, 0);   \
        o[d0] = __builtin_amdgcn_mfma_f32_32x32x16_bf16(pa2, (bf16x8){l2[0], l2[1], l2[2], l2[3], h2[0], h2[1], h2[2], h2[3]}, o[d0], 0, 0, 0);   \
        o[d0] = __builtin_amdgcn_mfma_f32_32x32x16_bf16(pa3, (bf16x8){l3[0], l3[1], l3[2], l3[3], h3[0], h3[1], h3[2], h3[3]}, o[d0], 0, 0, 0); } while (0)
    PV_D0(0); PV_D0(1); PV_D0(2); PV_D0(3);
#undef PV_D0
#undef TRRD
}
struct BlockRef { const bf16_t* Q; const bf16_t* K; const bf16_t* V; bf16_t* O; const float* C; int P0; int jlo; };
struct Seam { bf16x8 qr[8]; bf16x8 st_v0, st_v1, st_k0, st_k1; };
#define ROW(p, k0, rr) ((p) + (size_t)((k0) + (rr)) * RS + sc)
#define VMW() asm volatile("s_waitcnt vmcnt(0)" ::: "memory")
#define VMWN(n) asm volatile("s_waitcnt vmcnt(%0)" :: "i"(n) : "memory")
#define SLOAD_H(Kp, Vp, Cp, k0, bf) do { S.st_v0 = ld8(ROW(Vp, k0, sr)); S.st_v1 = ld8(ROW(Vp, k0, 32 + sr));              \
                         S.st_k0 = ld8(ROW(Kp, k0, sr)); S.st_k1 = ld8(ROW(Kp, k0, 32 + sr));                                 \
                         if (wid == 0) __builtin_amdgcn_global_load_lds((const unsigned*)((Cp) + (k0) + lane), (PG8_LAS unsigned*)(biasD + (bf) * 256), 4, 0, 0); } while (0)
#define SWRITE_HK(bf) do { *(bf16x8*)(K_lds + (bf) * SHM_K + kws) = S.st_k0; *(bf16x8*)(K_lds + (bf) * SHM_K + kws + 32 * 256) = S.st_k1; } while (0)
#define SWRITE_HV(bf) do { *(bf16x8*)(V_lds + (bf) * SHM_V + vst0) = S.st_v0; *(bf16x8*)(V_lds + (bf) * SHM_V + vst1) = S.st_v1; } while (0)
#define SWRITE_H(bf) do { SWRITE_HV(bf); SWRITE_HK(bf); } while (0)
DEVI void prime(const BlockRef& cur, char* lds, Seam& S, int wv) {
    const int tid = ltid(wv), wid = __builtin_amdgcn_readfirstlane(tid >> 6), lane = tid & 63, r32 = lane & 31, hi = lane >> 5;
    const int sr = tid >> 4, sc = (tid & 15) * 8, kws = KSWZ(sr, sc * 2); char* K_lds = lds + 2 * SHM_V; PG8_LAS unsigned char* biasD = (PG8_LAS unsigned char*)(lds + OFF_BIAS);
    const int kb0 = (cur.P0 / KVBLK + QB / KVBLK - 1) * KVBLK;
    for (int d0 = 0; d0 < 8; ++d0) S.qr[d0] = ld8(cur.Q + (size_t)(wid * QBLK + r32) * RS + d0 * 16 + hi * 8);
    SLOAD_H(cur.K, cur.V, cur.C, kb0, 0); VMW(); SWRITE_HK(0);
    __syncthreads();
}
DEVI void block(const BlockRef& cur, const BlockRef& nxt, char* lds, Seam& S, int wv) {
    const int tid = ltid(wv), wid = __builtin_amdgcn_readfirstlane(tid >> 6), lane = tid & 63, r32 = lane & 31, hi = lane >> 5;
    const int j_lo = cur.jlo;
    const int j_hi = (cur.P0 + QB - 1) / KVBLK + 1;
    const int NT = j_hi - j_lo;
    const int kbn = (nxt.P0 / KVBLK + QB / KVBLK - 1) * KVBLK;
    const int qlo = cur.P0 + wid * QBLK, qm = qlo + r32 - 4 * hi;
    char* V_lds = lds; char* K_lds = lds + 2 * SHM_V;
    float* ws = (float*)(lds + OFF_WS) + wid * 64; float* li_l = ws, * al_l = ws + 32;
    PG8_LAS unsigned char* biasD = (PG8_LAS unsigned char*)(lds + OFF_BIAS); const char* biasb = lds + OFF_BIAS;
    float m_reg = -1e30f, l_reg = 0; f32x16 o[4] = {};
    const int sr = tid >> 4, sc = (tid & 15) * 8, vst0 = v_st(sr, sc), vst1 = v_st(32 + sr, sc), kws = KSWZ(sr, sc * 2);
    const int vb0 = (int)(uintptr_t)V_lds + v_rd_base(lane);
    const bf16_t* Kh = cur.K; const bf16_t* Vh = cur.V; const float* Ch = cur.C;
#define RESC(a) do { if (__any((a) < 1.f)) { if (hi == 0) al_l[r32] = (a); asm volatile("s_waitcnt lgkmcnt(0)" ::: "memory");              \
                     for (int d_ = 0; d_ < 4; ++d_) for (int r = 0; r < 16; ++r) o[d_][r] *= al_l[crow(r, hi)]; } } while (0)
#define KBASE(t) ((j_hi - 1 - (t)) * KVBLK)
#define MASKT(P0_, P1_, t) do { const int kb_ = KBASE(t); if (kb_ + KVBLK - 1 > qlo) mask_tile(P0_, P1_, qm - kb_, WBIG); } while (0)
    constexpr int NQL = 8;
#define SEAM_K0() do { VMWN(NQL); SWRITE_HK(0); SBAR(); } while (0)
    f32x16 pA0, pA1, pB0, pB1; float mnA, mnB, alA, alB; bf16x8 pa0, pa1, pa2, pa3;
    SWRITE_HV(0); SBAR();
    if (NT > 1) { SLOAD_H(Kh, Vh, Ch, KBASE(1), 1); }
    SBAR(); qkt<0>(pA0, pA1, K_lds, biasb, r32, hi, S.qr);
    MASKT(pA0, pA1, 0); partialSM(pA0, pA1, m_reg, mnA, alA);
    if (NT > 1) { VMW(); SWRITE_H(1); }
    __syncthreads();
#define HALF_STEP(PX0, PX1, mnX, alX, PY0, PY1, alY, t, KB, VB, SB) do {                                                      \
        SBAR(); qkt<KB>(PX0, PX1, K_lds, biasb, r32, hi, S.qr);                                             \
        finishSM(PY0, PY1, alY, l_reg, pa0, pa1, pa2, pa3); SBAR();                                                           \
        if ((t) + 1 < NT) { SLOAD_H(Kh, Vh, Ch, KBASE((t) + 1), SB); SBAR(); }                                               \
        pv_tile<VB>(o, vb0, pa0, pa1, pa2, pa3); MASKT(PX0, PX1, (t)); partialSM(PX0, PX1, m_reg, mnX, alX);                                        \
        __syncthreads();                                                                                                      \
        if ((t) + 1 < NT) { VMW(); SWRITE_H(SB); }                                                                          \
        RESC(alX); __syncthreads(); } while (0)
    for (int t = 1; t + 1 < NT; t += 2) {
        HALF_STEP(pB0, pB1, mnB, alB, pA0, pA1, alA, t, 1, 0, 0);
        HALF_STEP(pA0, pA1, mnA, alA, pB0, pB1, alB, t + 1, 0, 1, 1);
    }
    const bool even = (NT & 1) == 0;
    if (even) { SBAR(); qkt<1>(pB0, pB1, K_lds, biasb, r32, hi, S.qr); SBAR(); }
    SLOAD_H(nxt.K, nxt.V, nxt.C, kbn, 0); SBAR();
#pragma unroll
    for (int d0 = 0; d0 < 8; ++d0) S.qr[d0] = ld8(nxt.Q + (size_t)(wid * QBLK + r32) * RS + d0 * 16 + hi * 8);
    SBAR();
    finishSM(pA0, pA1, alA, l_reg, pa0, pa1, pa2, pa3); SBAR();
    pv_tile<0>(o, vb0, pa0, pa1, pa2, pa3);
    if (even) { MASKT(pB0, pB1, NT - 1); partialSM(pB0, pB1, m_reg, mnB, alB); __syncthreads(); RESC(alB);
        finishSM(pB0, pB1, alB, l_reg, pa0, pa1, pa2, pa3); SBAR(); pv_tile<1>(o, vb0, pa0, pa1, pa2, pa3); }
    SBAR(); SEAM_K0();
    if (hi == 0) li_l[r32] = l_reg; asm volatile("s_waitcnt lgkmcnt(0)" ::: "memory");
    float rli[16];
#pragma unroll
    for (int r = 0; r < 16; ++r) rli[r] = __builtin_amdgcn_rcpf(li_l[crow(r, hi)]);
    bf16_t* Ow = cur.O + (size_t)(wid * QBLK) * RS;
#pragma unroll
    for (int r = 0; r < 16; ++r) { const int orow = crow(r, hi);
#pragma unroll
        for (int d0 = 0; d0 < 4; ++d0) { const float v = o[d0][r] * rli[r];
            const float vn = dpp<0xB1>(v);
            if ((r32 & 1) == 0) *(unsigned*)(Ow + (size_t)orow * RS + d0 * 32 + r32) = cvtpk(v, vn); } }
    __syncthreads();
#undef RESC
#undef KBASE
#undef MASKT
#undef SEAM_K0
#undef HALF_STEP
}
#undef ROW
#undef VMW
#undef VMWN
#undef SLOAD_H
#undef SWRITE_HK
#undef SWRITE_HV
#undef SWRITE_H
DEVI BlockRef mkref(int L, const bf16_t* Qb, const bf16_t* Kb, const bf16_t* Vb, bf16_t* Ob, const float* cs, const int* jlo) {
    BlockRef r; const int bh = L >> 6, qb = L & 63, b = bh >> 3, h = bh & 7;
    const size_t base = ((size_t)b * SEQ + (size_t)qb * QB) * RS + h * D, kvb = (size_t)b * SEQ * RS + h * D;
    r.Q = Qb + base; r.O = Ob + base; r.K = Kb + kvb; r.V = Vb + kvb; r.C = cs + (size_t)bh * SEQ; r.P0 = qb * QB; r.jlo = jlo[L];
    return r;
}
DEVI void phase(const bf16_t* Qb, const bf16_t* Kb, const bf16_t* Vb, bf16_t* Ob, const float* cs, const int* jlo, char* lds, int wv) {
    const int total = 16 * 64, stride = lgrid();
    const int bid_ = lbid();
    int L = (stride % 8 == 0) ? (bid_ % 8) * (stride / 8) + bid_ / 8 : bid_; if (L >= total) return;
    BlockRef cur = mkref(L, Qb, Kb, Vb, Ob, cs, jlo);
    Seam S;
    prime(cur, lds, S, wv);
    for (;;) {
        const bool last = L + stride >= total; const int Ln = last ? L : L + stride;
        const BlockRef nxt = last ? cur : mkref(Ln, Qb, Kb, Vb, Ob, cs, jlo);
        block(cur, nxt, lds, S, wv);
        if (last) break;
        cur = nxt; L = Ln;
    }
}
}

DEVI void norm_phase(const float* __restrict__ x, const float* __restrict__ gain, bf16_t* __restrict__ out,
                     const float* wf_src, const float* bf_src, float* logf, char* lds, int wv) {
    const int tid = ltid(wv), lane = tid & 63, wave = tid >> 6;
    float* wf = (float*)lds;
    if (wf_src) {
        for (int e = tid; e < 8192; e += 512) { const int k = e >> 3, h = e & 7; wf[h * 1024 + k] = wf_src[(size_t)k * NIN + 3072 + h]; }
        __syncthreads();
    }
    f32x4 g[4];
#pragma unroll
    for (int j = 0; j < 4; ++j) g[j] = *(const f32x4*)(gain + j * 256 + lane * 4);
    const int nw = lgrid() * 8;
    for (int row0 = lbid() * 8 + wave; row0 < T_TOK; row0 += 2 * nw) {
        f32x4 v[2][4]; float ss[2];
#pragma unroll
        for (int q = 0; q < 2; ++q) { const int row = row0 + q * nw < T_TOK ? row0 + q * nw : row0; const float* xr = x + (size_t)row * DM;
#pragma unroll
            for (int j = 0; j < 4; ++j) v[q][j] = *(const f32x4*)(xr + j * 256 + lane * 4); }
#pragma unroll
        for (int q = 0; q < 2; ++q) { float s_ = 0.f;
#pragma unroll
            for (int j = 0; j < 4; ++j) s_ += v[q][j][0] * v[q][j][0] + v[q][j][1] * v[q][j][1] + v[q][j][2] * v[q][j][2] + v[q][j][3] * v[q][j][3];
            ss[q] = wave_sum(s_); }
#pragma unroll
        for (int q = 0; q < 2; ++q) { const int row = row0 + q * nw; if (row >= T_TOK) break;
            const float rstd = __builtin_amdgcn_rsqf(ss[q] * (1.f / 1024.f) + 1e-6f);
#pragma unroll
            for (int j = 0; j < 4; ++j) { v[q][j] = v[q][j] * rstd * g[j]; u32x2 w; w.x = cvtpk(v[q][j][0], v[q][j][1]); w.y = cvtpk(v[q][j][2], v[q][j][3]); *(u32x2*)(out + (size_t)row * DM + j * 256 + lane * 4) = w; }
            if (wf_src) {
                float z = 0.f;
#pragma unroll
                for (int h = 0; h < 8; ++h) { float d = 0.f;
#pragma unroll
                    for (int j = 0; j < 4; ++j) { const f32x4 w = *(const f32x4*)(wf + h * 1024 + j * 256 + lane * 4); d += v[q][j][0] * w[0] + v[q][j][1] * w[1] + v[q][j][2] * w[2] + v[q][j][3] * w[3]; }
                    d = wave_sum(d); if (lane == h) z = d; }
                if (lane < 8) { z += bf_src[lane]; logf[((size_t)(row >> 14) * 8 + lane) * SEQ + (row & (SEQ - 1))] = fminf(z, 0.f) - __logf(1.f + __expf(-fabsf(z))); }
            }
        }
    }
    __syncthreads();
}

template <int KT, class F> DEVI void cvt_tile(F colptr, int ldsrc, int k0, bf16_t* out, int ldo, int v0, float* tile, int wv) {
    const int tid = ltid(wv);
    constexpr int PITCH = KT * 64 + 1;
    { const int vc = tid & 63, kk = tid >> 6; const float* cp = colptr(v0 + vc) + (size_t)k0 * ldsrc; float v[8 * KT];
#pragma unroll
      for (int r = 0; r < 8 * KT; ++r) v[r] = cp[(size_t)(r * 8 + kk) * ldsrc];
#pragma unroll
      for (int r = 0; r < 8 * KT; ++r) tile[vc * PITCH + r * 8 + kk] = v[r]; }
    __syncthreads();
    { const int vc = tid >> 3, k8 = (tid & 7) * 8;
#pragma unroll
      for (int q = 0; q < KT; ++q) { const float* tp = tile + vc * PITCH + q * 64 + k8;
        u32x4 w = {cvtpk(tp[0], tp[1]), cvtpk(tp[2], tp[3]), cvtpk(tp[4], tp[5]), cvtpk(tp[6], tp[7])};
        *(u32x4*)(out + (size_t)(v0 + vc) * ldo + k0 + q * 64 + k8) = w; } }
    __syncthreads();
}
struct ColGU { const float* wg; long du; DEVI const float* operator()(int v) const { return (const float*)((const char*)wg + (((v >> 7) & 1) ? du : 0l)) + (v >> 8) * 128 + (v & 127); } };
struct ColLin { const float* w; DEVI const float* operator()(int v) const { return w + v; } };
struct ColIn { const float* w; DEVI const float* operator()(int v) const { return w + (v < 3072 ? v : v + 8); } };
DEVI void cvt_ffn_phase(const float* wg, const float* wu, const float* wd, unsigned char* ws, char* lds, int j0, int jstride, int wv) {
    float* tile = (float*)(lds + 32768);
    bf16_t* Wgu = (bf16_t*)(ws + FFW_GU); bf16_t* Wd = (bf16_t*)(ws + FFW_D);
    for (int job = j0; job < 352 + 176; job += jstride) {
        if (job < 352) { const int vt = job >> 2, kg = job & 3; cvt_tile<4>(ColGU{wg, (long)((const char*)wu - (const char*)wg)}, DFF, kg * 256, Wgu, DM, vt * 64, tile, wv); }
        else { const int j = job - 352, vt = j / 11, kg = j % 11; cvt_tile<4>(ColLin{wd}, DM, kg * 256, Wd, DFF, vt * 64, tile, wv); }
    }
}
DEVI void cvt_mix_phase(const float* win, const float* woa, const float* wor, const float* wout, const float* lwa, const float* lwx, unsigned char* ws, char* lds, int wv) {
    float* tile = (float*)(lds + 32768);
    for (int job = lbid(); job < 448 + 192 + 32; job += lgrid()) {
        if (job < 448) { const int vt = job >> 2, kg = job & 3; cvt_tile<4>(ColIn{win}, NIN, kg * 256, (bf16_t*)(ws + WS_WIN), DM, vt * 64, tile, wv); }
        else if (job < 448 + 192) { const int j = job - 448, m = j >> 6, jj = j & 63, vt = jj >> 2, kg = jj & 3;
            const float* src = m == 0 ? woa : (m == 1 ? wor : wout);
            if (m < 2) cvt_tile<4>(ColLin{src}, DM, kg * 256, (bf16_t*)(ws + WS_WOA) + m * DM, 2 * DM, vt * 64, tile, wv);
            else cvt_tile<4>(ColLin{src}, DM, kg * 256, (bf16_t*)(ws + WS_WOUT), DM, vt * 64, tile, wv); }
        else { const int j = job - 448 - 192, gate = j >> 4, n = j & 15; const float* src = (gate ? lwx : lwa) + n * 4096;
            cvt_tile<1>(ColLin{src}, 64, 0, (bf16_t*)(ws + WS_LRU) + n * 8192 + gate * 4096, 64, 0, tile, wv); }
    }
}

DEVI void post_inproj_phase(const float* logf, float* cs, int* jlo, const float* qg, const float* kg, bf16_t* Qb, bf16_t* Kb, char* lds, int wv) {
    const int tid = ltid(wv), lane = tid & 63, wave = tid >> 6;
    if (lbid() < 16) {
        const int bh = lbid(), b = bh >> 3, h = bh & 7;
#define PADI(e) ((e) + ((e) >> 5))
        float* cL = (float*)lds;
        double* wt = (double*)(lds + 69632);
        float* sm = (float*)(lds + 69632 + 64);
        const float* lf = logf + (size_t)bh * SEQ + (size_t)tid * 32;
        float vals[32]; double tot = 0.0;
#pragma unroll
        for (int i = 0; i < 32; i += 4) { const f32x4 v4 = *(const f32x4*)(lf + i); vals[i] = v4[0]; vals[i + 1] = v4[1]; vals[i + 2] = v4[2]; vals[i + 3] = v4[3]; }
#pragma unroll
        for (int i = 0; i < 32; ++i) tot += (double)vals[i];
        double* dt = (double*)(lds + 69632 + 128);
        dt[tid] = tot;
        if (wave == 0) { float gq = fmaxf(fabsf(qg[lane]), fabsf(qg[lane + 64])), gk = fmaxf(fabsf(kg[lane]), fabsf(kg[lane + 64]));
            gq = wave_max(gq); gk = wave_max(gk);
            if (lane == 0) sm[0] = 2.f * 11.313708499f * gq * gk; }
        __syncthreads();
        if (tid < 8) { double a_ = 0.0; for (int i = 0; i < 64; ++i) a_ += dt[tid * 64 + i]; wt[tid] = a_; }
        __syncthreads();
        double run = 0.0; for (int w = 0; w < wave; ++w) run += wt[w];
        for (int i = 0; i < lane; ++i) run += dt[wave * 64 + i];
#pragma unroll
        for (int i = 0; i < 32; ++i) { run += (double)vals[i]; cL[tid * 33 + i] = (float)run; }
        __syncthreads();
#pragma unroll 4
        for (int j = 0; j < 32; ++j) { const int e = j * 512 + tid; cs[(size_t)bh * SEQ + e] = -cL[PADI(e)] * 11.313708499f; }
        if (tid < 64) {
            const int P0 = tid * 256, nj = P0 / 64; const float cP = cL[PADI(P0)], thr = -(104.f + sm[0]);
            int lo = 0, hi = nj;
            while (lo < hi) { const int mid = (lo + hi) >> 1; if (cP - cL[PADI(64 * mid + 63)] >= thr) hi = mid; else lo = mid + 1; }
            jlo[bh * 64 + tid] = lo;
        }
        __syncthreads();
    }
}

DEVI void rnn_local_phase(const bf16_t* xr, const float* convw, const float* convb, const bf16_t* lruT, const float* ba, const float* bx, const float* lam,
                          bf16_t* hloc, bf16_t* pcum, float* aggA, float* aggH, char* lds, int wv) {
    const int tid = ltid(wv), lane = tid & 63, wave = __builtin_amdgcn_readfirstlane(tid >> 6);
    bf16_t* xcb = (bf16_t*)lds;
    float* xcf = (float*)(lds + 18432);
    float* aL = xcf + 128 * 65;
    float* uL = aL + 128 * 65;
    float* segA = uL + 128 * 65;
    float* segH = segA + 512;
    float* cwL = segH + 512;
    const int G = lgrid(), bid = lbid(), ns = G >> 4;
    if (ns == 0 || bid >= ns * 16) return;
    const int cb = bid & 15, slot = bid >> 4, ch0 = cb * 64;
    if (tid < 320) cwL[tid] = tid < 256 ? convw[(tid >> 6) * 1024 + ch0 + (tid & 63)] : convb[ch0 + (tid & 63)];
    const int l16 = lane & 15, q4 = lane >> 4;
    bf16_t* WtL = (bf16_t*)(cwL + 320);
    { const bf16_t* Wt = lruT + cb * 8192;
#pragma unroll
      for (int i = 0; i < 2; ++i) { const int e = tid + i * 512, r = e >> 3, c8 = (e & 7) * 8; *(u32x4*)(WtL + r * 72 + c8) = *(const u32x4*)(Wt + r * 64 + c8); } }
    float bav[4], bxv[4], sp8[4];
#pragma unroll
    for (int cg = 0; cg < 4; ++cg) { const int ch = cg * 16 + l16; bav[cg] = ba[ch0 + ch]; bxv[cg] = bx[ch0 + ch]; const float lm = lam[ch0 + ch];
        sp8[cg] = 8.f * (fmaxf(-lm, 0.f) + __logf(1.f + __expf(-fabsf(lm)))); }
    const int tok = tid >> 2, cg4 = (tid & 3) * 16;
    u32x4 xw[8];
#define RNN_LOAD(j_) do { const int b_ = (j_) >> 7, t0_ = ((j_) & 127) * 128; _Pragma("unroll") for (int k = 0; k < 4; ++k) { const int s_ = t0_ + tok - 3 + k; \
        const bf16_t* p_ = xr + ((size_t)b_ * SEQ + (s_ < 0 ? 0 : s_)) * DM + ch0 + cg4; xw[2 * k] = *(const u32x4*)p_; xw[2 * k + 1] = *(const u32x4*)(p_ + 8); } } while (0)
#define LBAR() do { asm volatile("s_waitcnt lgkmcnt(0)" ::: "memory"); __builtin_amdgcn_s_barrier(); asm volatile("" ::: "memory"); } while (0)
    int j = slot;
    if (j < 256) RNN_LOAD(j);
    __syncthreads();
    for (; j < 256; j += ns) {
        const int b = j >> 7, chunk = j & 127, t0 = chunk * 128;
        {
            float xc[16];
#pragma unroll
            for (int i = 0; i < 16; i += 4) { const f32x4 bb = *(const f32x4*)(cwL + 256 + cg4 + i); xc[i] = bb[0]; xc[i + 1] = bb[1]; xc[i + 2] = bb[2]; xc[i + 3] = bb[3]; }
#pragma unroll
            for (int k = 0; k < 4; ++k) { const float zf = (t0 + tok - 3 + k) >= 0 ? 1.f : 0.f; const u32x4 w0 = xw[2 * k], w1 = xw[2 * k + 1];
                const float xv[16] = {bflo(w0.x), bfhi(w0.x), bflo(w0.y), bfhi(w0.y), bflo(w0.z), bfhi(w0.z), bflo(w0.w), bfhi(w0.w), bflo(w1.x), bfhi(w1.x), bflo(w1.y), bfhi(w1.y), bflo(w1.z), bfhi(w1.z), bflo(w1.w), bfhi(w1.w)};
#pragma unroll
                for (int i = 0; i < 16; i += 4) { const f32x4 cw = *(const f32x4*)(cwL + k * 64 + cg4 + i) * zf; xc[i] += cw[0] * xv[i]; xc[i + 1] += cw[1] * xv[i + 1]; xc[i + 2] += cw[2] * xv[i + 2]; xc[i + 3] += cw[3] * xv[i + 3]; } }
            if (j + ns < 256) RNN_LOAD(j + ns);
#pragma unroll
            for (int i = 0; i < 16; ++i) xcf[tok * 65 + cg4 + i] = xc[i];
            u32x4 o0 = {cvtpk(xc[0], xc[1]), cvtpk(xc[2], xc[3]), cvtpk(xc[4], xc[5]), cvtpk(xc[6], xc[7])}, o1 = {cvtpk(xc[8], xc[9]), cvtpk(xc[10], xc[11]), cvtpk(xc[12], xc[13]), cvtpk(xc[14], xc[15])};
            *(u32x4*)(xcb + tok * 72 + cg4) = o0; *(u32x4*)(xcb + tok * 72 + cg4 + 8) = o1;
        }
        LBAR();
        {
            const bf16x8 a0 = *(const bf16x8*)(xcb + (wave * 16 + l16) * 72 + q4 * 8), a1 = *(const bf16x8*)(xcb + (wave * 16 + l16) * 72 + 32 + q4 * 8);
#pragma unroll
            for (int cg = 0; cg < 4; ++cg) { const int ch = cg * 16 + l16;
                f32x4 ca = {0.f, 0.f, 0.f, 0.f}, cx = {0.f, 0.f, 0.f, 0.f};
                const bf16x8 wa0 = *(const bf16x8*)(WtL + ch * 72 + q4 * 8), wa1 = *(const bf16x8*)(WtL + ch * 72 + 32 + q4 * 8);
                const bf16x8 wx0 = *(const bf16x8*)(WtL + (64 + ch) * 72 + q4 * 8), wx1 = *(const bf16x8*)(WtL + (64 + ch) * 72 + 32 + q4 * 8);
                ca = __builtin_amdgcn_mfma_f32_16x16x32_bf16(a0, wa0, ca, 0, 0, 0); ca = __builtin_amdgcn_mfma_f32_16x16x32_bf16(a1, wa1, ca, 0, 0, 0);
                cx = __builtin_amdgcn_mfma_f32_16x16x32_bf16(a0, wx0, cx, 0, 0, 0); cx = __builtin_amdgcn_mfma_f32_16x16x32_bf16(a1, wx1, cx, 0, 0, 0);
#pragma unroll
                for (int i = 0; i < 4; ++i) { const int tk = wave * 16 + q4 * 4 + i; const float xv = xcf[tk * 65 + ch];
                    const float r = sigmoidf_(ca[i] + bav[cg]), ig = sigmoidf_(cx[i] + bxv[cg]), la = -r * sp8[cg], a = __expf(la);
                    const float y2 = 2.f * la; const float om = y2 < -0.05f ? 1.f - a * a : -y2 * (1.f + y2 * (0.5f + y2 * (0.16666667f + y2 * 0.041666668f)));
                    const float u = __builtin_amdgcn_sqrtf(fmaxf(om, 0.f)) * (ig * xv);
                    aL[tk * 65 + ch] = a; uL[tk * 65 + ch] = u; } }
        }
        LBAR();
        {
            float h = 0.f, P = 1.f;
#pragma unroll
            for (int i = 0; i < 16; ++i) { const int o = (wave * 16 + i) * 65 + lane; const float a = aL[o], u = uL[o]; h = a * h + u; P *= a; uL[o] = h; aL[o] = P; }
            segA[wave * 64 + lane] = P; segH[wave * 64 + lane] = h;
        }
        LBAR();
        {
            float Ain = 1.f, Hin = 0.f;
            for (int s = 0; s < wave; ++s) { const float As = segA[s * 64 + lane], Hs = segH[s * 64 + lane]; Hin = As * Hin + Hs; Ain *= As; }
            const size_t gbase = ((size_t)b * SEQ + t0 + wave * 16) * DM + ch0 + lane;
            float hl = 0.f, pc = 0.f;
#pragma unroll
            for (int i = 0; i < 16; ++i) { const int o = (wave * 16 + i) * 65 + lane; hl = uL[o] + aL[o] * Hin; pc = aL[o] * Ain;
                hloc[gbase + (size_t)i * DM] = (bf16_t)(cvtpk(hl, hl) & 0xffffu); pcum[gbase + (size_t)i * DM] = (bf16_t)(cvtpk(pc, pc) & 0xffffu); }
            if (wave == 7) { const size_t ao = ((size_t)b * 128 + chunk) * 1024 + ch0 + lane; aggA[ao] = pc; aggH[ao] = hl; }
        }
    }
#undef RNN_LOAD
#undef LBAR
    __syncthreads();
}
DEVI void rnn_carry_phase(const float* aggA, const float* aggH, float* carry, int wv) {
    const int g = lbid() * 512 + ltid(wv);
    if (g < 2048) { const int b = g >> 10, ch = g & 1023; float H = 0.f;
        for (int c0 = 0; c0 < 128; c0 += 64) { float A[64], Hh[64];
#pragma unroll
            for (int i = 0; i < 64; ++i) { const size_t o = ((size_t)b * 128 + c0 + i) * 1024 + ch; A[i] = aggA[o]; Hh[i] = aggH[o]; }
#pragma unroll
            for (int i = 0; i < 64; ++i) { carry[((size_t)b * 128 + c0 + i) * 1024 + ch] = H; H = A[i] * H + Hh[i]; } } }
}
DEVI void rnn_fix_phase(const bf16_t* hloc, const bf16_t* pcum, const float* carry, bf16_t* gr_yr, int wv) {
    const size_t nvec = (size_t)T_TOK * DM / 8, stride = (size_t)lgrid() * 512;
    for (size_t idx0 = (size_t)lbid() * 512 + ltid(wv); idx0 < nvec; idx0 += 2 * stride) {
        u32x4 hw[2], pw[2], gw[2]; f32x4 c0[2], c1[2];
#pragma unroll
        for (int q = 0; q < 2; ++q) { const size_t idx = idx0 + q * stride; if (idx >= nvec) break; const size_t row = idx >> 7; const int c8 = (int)(idx & 127) * 8; const int b = (int)(row >> 14), chunk = (int)((row & 16383) >> 7);
            hw[q] = *(const u32x4*)(hloc + idx * 8); pw[q] = *(const u32x4*)(pcum + idx * 8); gw[q] = *(const u32x4*)(gr_yr + idx * 8);
            const float* cp = carry + ((size_t)b * 128 + chunk) * 1024 + c8; c0[q] = *(const f32x4*)cp; c1[q] = *(const f32x4*)(cp + 4); }
#pragma unroll
        for (int q = 0; q < 2; ++q) { const size_t idx = idx0 + q * stride; if (idx >= nvec) break;
            const float hv[8] = {bflo(hw[q].x), bfhi(hw[q].x), bflo(hw[q].y), bfhi(hw[q].y), bflo(hw[q].z), bfhi(hw[q].z), bflo(hw[q].w), bfhi(hw[q].w)};
            const float pv[8] = {bflo(pw[q].x), bfhi(pw[q].x), bflo(pw[q].y), bfhi(pw[q].y), bflo(pw[q].z), bfhi(pw[q].z), bflo(pw[q].w), bfhi(pw[q].w)};
            const float gv[8] = {bflo(gw[q].x), bfhi(gw[q].x), bflo(gw[q].y), bfhi(gw[q].y), bflo(gw[q].z), bfhi(gw[q].z), bflo(gw[q].w), bfhi(gw[q].w)};
            const float cv[8] = {c0[q][0], c0[q][1], c0[q][2], c0[q][3], c1[q][0], c1[q][1], c1[q][2], c1[q][3]};
            float y[8];
#pragma unroll
            for (int i = 0; i < 8; ++i) { const float x = gv[i], z = 1.5957691216f * (x + 0.044715f * x * x * x); y[i] = (hv[i] + pv[i] * cv[i]) * x * sigmoidf_(z); }
            u32x4 o = {cvtpk(y[0], y[1]), cvtpk(y[2], y[3]), cvtpk(y[4], y[5]), cvtpk(y[6], y[7])};
            *(u32x4*)(gr_yr + idx * 8) = o; }
    }
}

struct Args { const float* in[24]; float* out; unsigned char* ws; int ph_lo, ph_hi; };
enum { I_X = 0, I_F1N, I_F1G, I_F1U, I_F1D, I_MIXN, I_WIN, I_BIN, I_QN, I_KN, I_CW, I_CB, I_LWA, I_LBA, I_LWX, I_LBX, I_LAM, I_WOA, I_WOR, I_WOUT, I_F2N, I_F2G, I_F2U, I_F2D };

__global__ void __launch_bounds__(512, 2) fwd_mega(Args a) {
    extern __shared__ __attribute__((aligned(16))) unsigned char lds[];
    cg::grid_group grid = cg::this_grid();
    char* ldc = (char*)lds; PG8_LAS unsigned char* ldl = (PG8_LAS unsigned char*)lds;
    const int wv = __builtin_amdgcn_readfirstlane((int)(threadIdx.x >> 6));
    if (threadIdx.x < 4) ((LAS unsigned*)(lds + LDS_BAR))[threadIdx.x] = 0u;
    __syncthreads();
    (void)xcd_barrier_post((unsigned*)(a.ws + WS_BAR), (volatile LAS unsigned*)(lds + LDS_BAR), wv);
#define GBAR() do { XcdBarrier xb_; xb_.bar = (unsigned*)(ws + WS_BAR); xb_.x = xb_xcc_id(); xb_.st = (volatile LAS unsigned*)(lds + LDS_BAR); xcd_barrier(xb_, wv); } while (0)
    for (int ph = a.ph_lo; ph < a.ph_hi; ++ph) {
        const int G = lgrid(), bid = lbid();
        int zi = 0; asm volatile("" : "+s"(zi));
#define IN(i) a.in[(i) + zi]
        unsigned char* ws = a.ws; float* xo = a.out;
        asm volatile("" : "+s"(ws), "+s"(xo));
        bf16_t* U0 = (bf16_t*)ws; bf16_t* U1 = (bf16_t*)(ws + UNIT); bf16_t* U2 = (bf16_t*)(ws + 2 * UNIT); bf16_t* U3 = (bf16_t*)(ws + 3 * UNIT);
        bf16_t* U4 = (bf16_t*)(ws + 4 * UNIT); bf16_t* U5 = (bf16_t*)(ws + 5 * UNIT); bf16_t* U6 = (bf16_t*)(ws + 6 * UNIT); bf16_t* U7 = (bf16_t*)(ws + 7 * UNIT);
        const int l = ph >> 4, p = ph & 15;
        if (p == 11) continue;
        const size_t oF = (size_t)l * DM * DFF;
#ifdef ONLY
        if (p != ONLY) continue;
#endif
        for (int rep = 0; rep < (((REPEAT_MASK >> p) & 1) ? 2 : 1); ++rep) {
        if (rep) GBAR();
        switch (p) {
        case 0: {
            cvt_ffn_phase(IN(I_F1G) + oF, IN(I_F1U) + oF, IN(I_F1D) + oF, ws, ldc, bid, G, wv);
            norm_phase(l == 0 ? IN(I_X) : xo, IN(I_F1N) + l * DM, U0, nullptr, nullptr, nullptr, ldc, wv);
        } break;
        case 13:
            norm_phase(xo, IN(I_F2N) + l * DM, U0, nullptr, nullptr, nullptr, ldc, wv);
            break;
        case 1: case 14: {
            pg8::Gemm g{U0, (const bf16_t*)(ws + FFW_GU), T_TOK, 2 * DFF, DM, nullptr, DM}; pg8::StaticOrder S; S.init(T_TOK, 2 * DFF, G, bid);
            EpiUp E{U1}; pg8::gemm_phase(ldl, g, S, E, wv);
        } break;
        case 2: case 15: {
            pg8::Gemm g{U1, (const bf16_t*)(ws + FFW_D), T_TOK, DM, DFF, nullptr, DFF}; pg8::StaticOrder S; S.init(T_TOK, DM, G, bid);
            EpiRes E{(l == 0 && p == 2) ? IN(I_X) : xo, xo, 0.5f}; pg8::gemm_phase(ldl, g, S, E, wv);
        } break;
        case 3: {
            cvt_mix_phase(IN(I_WIN) + (size_t)l * DM * NIN, IN(I_WOA) + (size_t)l * DM * DM, IN(I_WOR) + (size_t)l * DM * DM, IN(I_WOUT) + (size_t)l * DM * DM,
                          IN(I_LWA) + (size_t)l * 65536, IN(I_LWX) + (size_t)l * 65536, ws, ldc, wv);
            norm_phase(xo, IN(I_MIXN) + l * DM, U0, IN(I_WIN) + (size_t)l * DM * NIN, IN(I_BIN) + (size_t)l * NIN + 3072, (float*)(ws + WS_LOGF), ldc, wv);
        } break;
        case 4: {
            pg8::Gemm g{U0, (const bf16_t*)(ws + WS_WIN), T_TOK, NINP, DM, nullptr, DM}; pg8::StaticOrder S; S.init(T_TOK, NINP, G, bid);
            EpiInProj E{ws, IN(I_BIN) + (size_t)l * NIN, IN(I_QN) + l * 128, IN(I_KN) + l * 128, (float*)(ldc + 131072)}; pg8::gemm_phase(ldl, g, S, E, wv);
        } break;
        case 5:
            post_inproj_phase((const float*)(ws + WS_LOGF), (float*)(ws + WS_CS), (int*)(ws + WS_JLO), IN(I_QN) + l * 128, IN(I_KN) + l * 128, U1, U2, ldc, wv);
            break;
        case 6:
            att::phase(U1, U2, U3, U0, (const float*)(ws + WS_CS), (const int*)(ws + WS_JLO), ldc, wv);
            break;
        case 7:
            rnn_local_phase(U4, IN(I_CW) + l * 4096, IN(I_CB) + l * 1024, (const bf16_t*)(ws + WS_LRU), IN(I_LBA) + l * 1024, IN(I_LBX) + l * 1024, IN(I_LAM) + l * 1024,
                            U2, U3, (float*)(ws + WS_AGGA), (float*)(ws + WS_AGGH), ldc, wv);
            break;
        case 8:
            if (bid < 4 || G < 8) rnn_carry_phase((const float*)(ws + WS_AGGA), (const float*)(ws + WS_AGGH), (float*)(ws + WS_CARRY), wv);
            if (G < 8) cvt_ffn_phase(IN(I_F2G) + oF, IN(I_F2U) + oF, IN(I_F2D) + oF, ws, ldc, bid, G, wv);
            else if (bid >= 4) cvt_ffn_phase(IN(I_F2G) + oF, IN(I_F2U) + oF, IN(I_F2D) + oF, ws, ldc, bid - 4, G - 4, wv);
            break;
        case 9:
            rnn_fix_phase(U2, U3, (const float*)(ws + WS_CARRY), U5, wv);
            break;
        case 10: {
            pg8::Gemm g{U0, (const bf16_t*)(ws + WS_WOA), T_TOK, DM, 2 * DM, U5, DM}; pg8::StaticOrder S; S.init(T_TOK, DM, G, bid);
            EpiMergeF E{U6, U7, U2}; pg8::gemm_phase(ldl, g, S, E, wv);
        } break;
        case 12: {
            pg8::Gemm g{U2, (const bf16_t*)(ws + WS_WOUT), T_TOK, DM, DM, nullptr, DM}; pg8::StaticOrder S; S.init(T_TOK, DM, G, bid);
            EpiRes E{xo, xo, 1.0f}; pg8::gemm_phase(ldl, g, S, E, wv);
        } break;
        }
        }
        if (ph + 1 < a.ph_hi) { if (ph == a.ph_lo) grid.sync(); else for (int sr_ = 0; sr_ < SYNC_REPS; ++sr_) GBAR(); }
    }
}

extern "C" void kernel_launch(void* const* d_in, const int* in_sizes, int n_in, void* d_out, int out_size, void* d_ws, size_t ws_size, hipStream_t stream) {
    static int grid_blocks = 0;
    if (grid_blocks == 0) {
        if (n_in != 24 || ws_size < WS_END) { fprintf(stderr, "kernel_launch: unexpected n_in %d / ws_size %zu (need %zu)\n", n_in, ws_size, (size_t)WS_END); grid_blocks = -1; return; }
        int dev = 0, cus = 0, per_cu = 0;
        (void)hipGetDevice(&dev); (void)hipDeviceGetAttribute(&cus, hipDeviceAttributeMultiprocessorCount, dev);
        if (hipFuncSetAttribute((const void*)fwd_mega, hipFuncAttributeMaxDynamicSharedMemorySize, LDS_BYTES) != hipSuccess) { fprintf(stderr, "kernel_launch: hipFuncSetAttribute failed\n"); grid_blocks = -1; return; }
        if (hipOccupancyMaxActiveBlocksPerMultiprocessor(&per_cu, (const void*)fwd_mega, 512, LDS_BYTES) != hipSuccess || per_cu < 1) { fprintf(stderr, "kernel_launch: occupancy query gave %d\n", per_cu); per_cu = 1; }
        (void)hipGetLastError();
        grid_blocks = cus;
        fprintf(stderr, "kernel_launch: grid %d (per_cu %d), ws %zu need %zu\n", grid_blocks, per_cu, ws_size, (size_t)WS_END);
    }
    if (grid_blocks < 0) return;
    (void)hipMemsetAsync((char*)d_ws + WS_BAR, 0, 16384, stream);
    Args a{};
    for (int i = 0; i < 24; ++i) a.in[i] = (const float*)d_in[i];
    a.out = (float*)d_out; a.ws = (unsigned char*)d_ws; a.ph_lo = 0; a.ph_hi = DEPTH * 16;
    void* args[] = {&a};
    hipError_t e = hipLaunchCooperativeKernel((const void*)fwd_mega, dim3(grid_blocks), dim3(512), args, LDS_BYTES, stream);
    if (e != hipSuccess) fprintf(stderr, "cooperative launch failed: %s (grid %d)\n", hipGetErrorString(e), grid_blocks);
}
```

```cpp
#include <hip/hip_runtime.h>
#include <hip/hip_cooperative_groups.h>
#include <cstdio>
#include <cstdint>
namespace cg = cooperative_groups;

#define DEVI __device__ __forceinline__
typedef unsigned short bf16_t;
typedef short bf16x8 __attribute__((ext_vector_type(8)));
typedef short s16x4 __attribute__((ext_vector_type(4)));
typedef float f32x4 __attribute__((ext_vector_type(4)));
typedef float f32x16 __attribute__((ext_vector_type(16)));
typedef unsigned u32x4 __attribute__((ext_vector_type(4)));
typedef unsigned u32x2 __attribute__((ext_vector_type(2)));

constexpr int T_TOK = 32768, SEQ = 16384, DM = 1024, DFF = 2816, NIN = 7176, NINP = 7168, DEPTH = 4;
constexpr size_t UNIT = (size_t)T_TOK * DM * 2;
constexpr size_t WS_WIN = 8 * UNIT;
constexpr size_t WS_WOA = WS_WIN + (size_t)NINP * DM * 2;
constexpr size_t WS_WOR = WS_WOA + (size_t)DM * DM * 2;
constexpr size_t WS_WOUT = WS_WOR + (size_t)DM * DM * 2;
constexpr size_t WS_LRU = WS_WOUT + (size_t)DM * DM * 2;
constexpr size_t WS_LOGF = WS_LRU + 16 * 128 * 64 * 2;
constexpr size_t WS_CS = WS_LOGF + (size_t)T_TOK * 8 * 4;
constexpr size_t WS_JLO = WS_CS + (size_t)16 * SEQ * 4;
constexpr size_t WS_AGGA = WS_JLO + 4096;
constexpr size_t WS_AGGH = WS_AGGA + (size_t)2 * 128 * 1024 * 4;
constexpr size_t WS_CARRY = WS_AGGH + (size_t)2 * 128 * 1024 * 4;
constexpr size_t WS_BAR = WS_CARRY + (size_t)2 * 128 * 1024 * 4;
constexpr size_t WS_END = WS_BAR + 16384;
constexpr size_t FFW_GU = 4 * UNIT;
constexpr size_t FFW_D = FFW_GU + (size_t)2 * DFF * DM * 2;
constexpr int LDS_BAR = 147456;
constexpr int LDS_BYTES = LDS_BAR + 16;
#ifndef REPEAT_MASK
#define REPEAT_MASK 0x0
#endif
#ifndef SYNC_REPS
#define SYNC_REPS 1
#endif

DEVI unsigned cvtpk(float lo, float hi) { unsigned r; asm volatile("v_cvt_pk_bf16_f32 %0, %1, %2" : "=v"(r) : "v"(lo), "v"(hi)); return r; }
DEVI float bflo(unsigned w) { return __uint_as_float(w << 16); }
DEVI float bfhi(unsigned w) { return __uint_as_float(w & 0xffff0000u); }
DEVI float sigmoidf_(float x) { return __builtin_amdgcn_rcpf(1.f + __expf(-x)); }
DEVI int ltid(int wv) { int t = (wv << 6) | (int)__builtin_amdgcn_mbcnt_hi(~0u, __builtin_amdgcn_mbcnt_lo(~0u, 0u)); asm volatile("" : "+v"(t)); return t; }
DEVI int lbid() { int t = blockIdx.x; asm volatile("" : "+s"(t)); return t; }
DEVI int lgrid() { int t = gridDim.x; asm volatile("" : "+s"(t)); return t; }
template <int CTRL> DEVI float dpp(float x) { return __builtin_bit_cast(float, __builtin_amdgcn_mov_dpp(__builtin_bit_cast(int, x), CTRL, 0xf, 0xf, true)); }
DEVI float xrow16_sum(float x) {
    auto s = __builtin_amdgcn_permlane16_swap(__float_as_uint(x), __float_as_uint(x), false, false);
    x = __uint_as_float(s[0]) + __uint_as_float(s[1]);
    auto t = __builtin_amdgcn_permlane32_swap(__float_as_uint(x), __float_as_uint(x), false, false);
    return __uint_as_float(t[0]) + __uint_as_float(t[1]);
}
DEVI float xrow16_max(float x) {
    auto s = __builtin_amdgcn_permlane16_swap(__float_as_uint(x), __float_as_uint(x), false, false);
    x = fmaxf(__uint_as_float(s[0]), __uint_as_float(s[1]));
    auto t = __builtin_amdgcn_permlane32_swap(__float_as_uint(x), __float_as_uint(x), false, false);
    return fmaxf(__uint_as_float(t[0]), __uint_as_float(t[1]));
}
DEVI float wave_sum(float v) { v += dpp<0xB1>(v); v += dpp<0x4E>(v); v += dpp<0x124>(v); v += dpp<0x128>(v); return xrow16_sum(v); }
DEVI float wave_max(float v) { v = fmaxf(v, dpp<0xB1>(v)); v = fmaxf(v, dpp<0x4E>(v)); v = fmaxf(v, dpp<0x124>(v)); v = fmaxf(v, dpp<0x128>(v)); return xrow16_max(v); }


#define XB_TMO      128
#define XB_XCNT(j)  (256  + 64 * (j))
#define XB_XSUB(j)  (1280 + 64 * (j))
#define XB_XGEN(j)  (2304 + 64 * (j))
#define XB_TOP      3328
#define XB_TOPGEN   3392
#define XCD_BAR_WORDS 3456
#define XB_SPIN_CAP (1u << 20)
#define LAS __attribute__((address_space(3)))
DEVI unsigned xb_ld(unsigned* p)              { return __hip_atomic_load(p, __ATOMIC_RELAXED, __HIP_MEMORY_SCOPE_AGENT); }
DEVI unsigned xb_add(unsigned* p, unsigned v) { return __hip_atomic_fetch_add(p, v, __ATOMIC_RELAXED, __HIP_MEMORY_SCOPE_AGENT); }
DEVI unsigned xb_xcc_id() { return (unsigned)__builtin_amdgcn_s_getreg((3 << 11) | 20) & 0xFu; }
#define XB_SPIN(cond, bar) do { unsigned _sp = 0; while (cond) { __builtin_amdgcn_s_sleep(1); \
    if ((++_sp & 255u) == 0u) { if (xb_ld(&(bar)[XB_TMO])) break; if (_sp > XB_SPIN_CAP) { atomicAdd(&(bar)[XB_TMO], 1u); break; } } } } while (0)
struct XcdBarrier { unsigned* bar; unsigned x; volatile LAS unsigned* st; };
DEVI XcdBarrier xcd_barrier_post(unsigned* bar, volatile LAS unsigned* st, int wv) {
    XcdBarrier b; b.bar = bar; b.x = xb_xcc_id(); b.st = st;
    if (ltid(wv) == 0) (void)xb_add(&bar[XB_XCNT(b.x)], 1u);
    return b;
}
DEVI void xcd_barrier_complete(unsigned* bar, unsigned x, unsigned& nloc, unsigned& nx) {
    const unsigned G = gridDim.x * gridDim.y * gridDim.z;
    unsigned sum, cnt, mine, sp = 0u;
    for (;;) {
        sum = 0u; cnt = 0u; mine = 0u;
#pragma unroll
        for (unsigned j = 0; j < 16; ++j) { const unsigned c = xb_ld(&bar[XB_XCNT(j)]); sum += c; cnt += (c > 0u) ? 1u : 0u; mine = (j == x) ? c : mine; }
        if (sum == G) break;
        __builtin_amdgcn_s_sleep(1);
        if ((++sp & 255u) == 0u) { if (xb_ld(&bar[XB_TMO])) break; if (sp > XB_SPIN_CAP) { atomicAdd(&bar[XB_TMO], 1u); break; } }
    }
    nloc = mine > 0u ? mine : 1u; nx = cnt > 0u ? cnt : 1u;
}
DEVI void xcd_barrier(const XcdBarrier& b, int wv) {
    asm volatile("s_waitcnt vmcnt(0)" ::: "memory");
    __syncthreads();
    if (ltid(wv) == 0) {
        unsigned* bar = b.bar;
        __builtin_amdgcn_s_waitcnt(0);
        unsigned nloc = b.st[0], nx = b.st[1];
        if (nloc == 0u) { xcd_barrier_complete(bar, b.x, nloc, nx); b.st[0] = nloc; b.st[1] = nx; }
        const unsigned old = xb_add(&bar[XB_XSUB(b.x)], 1u);
        const unsigned gen = old / nloc;
        if (old + 1u == (gen + 1u) * nloc) {
            __builtin_amdgcn_fence(__ATOMIC_RELEASE, "agent");
            asm volatile("s_waitcnt vmcnt(0)" ::: "memory");
            const unsigned og = xb_add(&bar[XB_TOP], 1u);
            const unsigned tg = og / nx;
            if (og + 1u == (tg + 1u) * nx) xb_add(&bar[XB_TOPGEN], 1u);
            else XB_SPIN(xb_ld(&bar[XB_TOPGEN]) == tg, bar);
            __builtin_amdgcn_fence(__ATOMIC_ACQUIRE, "agent");
            xb_add(&bar[XB_XGEN(b.x)], 1u);
            asm volatile("s_waitcnt vmcnt(0)" ::: "memory");
        } else {
            XB_SPIN(xb_ld(&bar[XB_XGEN(b.x)]) == gen, bar);
            __builtin_amdgcn_fence(__ATOMIC_ACQUIRE, "agent");
            asm volatile("s_waitcnt vmcnt(0)" ::: "memory");
        }
    }
    __syncthreads();
}

namespace pg8 {
#define PG8_LAS __attribute__((address_space(3)))
constexpr int BM = 256, BK = 64, HALF = 128, HTB = HALF * BK * 2, STAGE_BYTES = 8 * HTB, NXCD = 8, WGM = 8;
__host__ __device__ __forceinline__ int lds_byte(int r, int c) { const int st = (r >> 4) * 2 + (c >> 5), rr = r & 15, cc = c & 31, ob = rr * 64 + cc * 2; return st * 1024 + (ob ^ (((ob >> 9) & 1) << 5)); }
__host__ __device__ __forceinline__ void stage_rc(int b, int& R, int& C) { const int st = b / 1024, sb = b % 1024, swz = sb ^ (((sb >> 9) & 1) << 5); R = (st >> 1) * 16 + swz / 64; C = (st & 1) * 32 + (swz % 64) / 2; }
struct Unit { int pm, pn; };
__host__ __device__ __forceinline__ int perm32(int rho) { const int n = rho >> 4, i = rho & 15; return 8 * (i >> 2) + 4 * n + (i & 3); }
struct Gemm { const bf16_t* A; const bf16_t* Bt; int M, N, K; const bf16_t* A2; int lda; };
struct StaticOrder {
    int nM, nN, nwg, G, c;
    __device__ void init(int M, int N, int G_, int c_) { nM = M / BM; nN = N / BM; nwg = nM * nN; G = G_; c = c_; }
    __device__ bool next(int i, Unit& u) const {
        const long L = (long)i * G + c; if (L >= nwg) return false;
        int wgid = (int)L; { const int q = nwg / NXCD, r = nwg % NXCD, xcd = wgid % NXCD, off = wgid / NXCD; wgid = (xcd < r ? xcd * (q + 1) : r * (q + 1) + (xcd - r) * q) + off; }
        const int nig = WGM * nN, gid = wgid / nig, fm = gid * WGM, gsz = (nM - fm) < WGM ? (nM - fm) : WGM;
        u.pm = fm + ((wgid % nig) % gsz); u.pn = (wgid % nig) / gsz; return true;
    }
};
template <class Epi, class Sched>
__device__ __forceinline__ void gemm_phase(PG8_LAS unsigned char* lds, const Gemm g, const Sched& S, const Epi& E, int wv) {
    const int tid = ltid(wv), wid = __builtin_amdgcn_readfirstlane(tid >> 6), lane = tid & 63, wr = wid >> 2, wc = wid & 3, fr = lane & 15, fq = lane >> 4;
    const int K = g.K, nt = K / BK;
    unsigned voffA[2], voffB[2];
    const int lda = g.lda;
#pragma unroll
    for (int i = 0; i < 2; ++i) { int R, C; stage_rc(tid * 16 + i * 8192, R, C); const int Rb = Epi::PERM ? ((R & ~31) + perm32(R & 31)) : R;
        voffA[i] = (unsigned)(R * lda + C) * 2u; voffB[i] = (unsigned)(Rb * K + C) * 2u; }
    const size_t kstep = (size_t)(BK * 2);
    const size_t hstepA = (size_t)HALF * lda * 2, hstep = (size_t)HALF * K * 2;
    const size_t tstepA = 2 * hstepA, tstep = 2 * hstep;
    constexpr bool SPLIT = Epi::SPLIT;
    const int ksp = nt >> 1;
    const unsigned ldsw = (unsigned)wid * 1024u;
    const int aoff = lds_byte(wr * 64 + fr, fq * 8), boff = lds_byte(wc * 32 + fr, fq * 8);
#define PG8_SA(b, h) (((b) * 2 + (h)) * HTB)
#define PG8_SB(b, h) ((4 + (b) * 2 + (h)) * HTB)
#define PG8_STAGE(bufoff, gbase, voff) do { _Pragma("unroll") for (int _i = 0; _i < 2; ++_i) \
        __builtin_amdgcn_global_load_lds((const unsigned*)((const char*)(gbase) + (voff)[_i]), (PG8_LAS unsigned*)(lds + (bufoff) + ldsw + _i * 8192), 16, 0, 0); } while (0)
#define PG8_LDA(dst, b, h) do { _Pragma("unroll") for (int m = 0; m < 4; ++m) _Pragma("unroll") for (int k = 0; k < 2; ++k) dst[m][k] = *(const PG8_LAS bf16x8*)(lds + PG8_SA(b, h) + aoff + m * 2048 + k * 1024); } while (0)
#define PG8_LDB(dst, b, h) do { _Pragma("unroll") for (int n = 0; n < 2; ++n) _Pragma("unroll") for (int k = 0; k < 2; ++k) dst[n][k] = *(const PG8_LAS bf16x8*)(lds + PG8_SB(b, h) + boff + n * 2048 + k * 1024); } while (0)
#define PG8_MMA(ai, bj, At, Bt) do { __builtin_amdgcn_s_setprio(1); _Pragma("unroll") for (int m = 0; m < 4; ++m) _Pragma("unroll") for (int n = 0; n < 2; ++n) _Pragma("unroll") for (int k = 0; k < 2; ++k) \
        acc[ai][bj][m][n] = __builtin_amdgcn_mfma_f32_16x16x32_bf16(Bt[n][k], At[m][k], acc[ai][bj][m][n], 0, 0, 0); __builtin_amdgcn_s_setprio(0); } while (0)
#define PG8_WAIT_V(n) asm volatile("s_waitcnt vmcnt(" #n ")" ::: "memory")
#define PG8_WAIT_L(n) asm volatile("s_waitcnt lgkmcnt(" #n ")" ::: "memory")
#define PG8_BAR __builtin_amdgcn_s_barrier()
#define PG8_SCHED __builtin_amdgcn_sched_barrier(0)
    Unit cur, nxt; int ui = 0;
    if (!S.next(0, cur)) return;
    f32x4 acc[2][2][4][2];
#pragma unroll
    for (int a = 0; a < 2; ++a)
#pragma unroll
        for (int b = 0; b < 2; ++b)
#pragma unroll
            for (int m = 0; m < 4; ++m)
#pragma unroll
                for (int n = 0; n < 2; ++n) acc[a][b][m][n] = (f32x4){0.f, 0.f, 0.f, 0.f};
    bf16x8 At[4][2], B0[2][2], B1[2][2];
    const char* cA = (const char*)g.A + (size_t)cur.pm * tstepA; const char* cB = (const char*)g.Bt + (size_t)cur.pn * tstep;
    const long dA2 = SPLIT ? ((const char*)g.A2 - (const char*)g.A) - (long)ksp * (long)kstep : 0l;
    PG8_STAGE(PG8_SB(0, 0), cB, voffB); PG8_STAGE(PG8_SA(0, 0), cA, voffA); PG8_STAGE(PG8_SB(0, 1), cB + hstep, voffB); PG8_STAGE(PG8_SA(0, 1), cA + hstepA, voffA);
    if (wr == 1) PG8_BAR;
    PG8_WAIT_V(4); PG8_BAR;
    PG8_STAGE(PG8_SB(1, 0), cB + kstep, voffB); PG8_STAGE(PG8_SA(1, 0), cA + kstep, voffA); PG8_STAGE(PG8_SB(1, 1), cB + hstep + kstep, voffB);
    PG8_WAIT_V(6); PG8_BAR;
    for (;;) {
        const bool has_next = S.next(ui + 1, nxt);
        const char* nA = has_next ? (const char*)g.A + (size_t)nxt.pm * tstepA : cA; const char* nB = has_next ? (const char*)g.Bt + (size_t)nxt.pn * tstep : cB;
        for (int t = 0; t < nt; t += 2) {
            const bool last = (t == nt - 2);
            if constexpr (Epi::MID) { if (t == ksp) E.mid(acc, cur, wr, wc, fr, fq); }
            const char* a1 = cA + (size_t)(t + 1) * kstep + ((SPLIT && t >= ksp) ? dA2 : 0l);
            const char* a2 = last ? nA : cA + (size_t)(t + 2) * kstep + ((SPLIT && t + 2 >= ksp) ? dA2 : 0l); const char* b2 = last ? nB : cB + (size_t)(t + 2) * kstep;
            const char* a3 = a2 + kstep; const char* b3 = b2 + kstep;
            PG8_LDB(B0, 0, 0); PG8_SCHED; PG8_LDA(At, 0, 0); PG8_STAGE(PG8_SA(1, 1), a1 + hstepA, voffA);
            PG8_WAIT_L(8); PG8_BAR; PG8_WAIT_L(0); PG8_MMA(0, 0, At, B0); PG8_BAR; PG8_SCHED;
            PG8_LDB(B1, 0, 1); PG8_STAGE(PG8_SB(0, 0), b2, voffB);
            PG8_BAR; PG8_WAIT_L(0); PG8_MMA(0, 1, At, B1); PG8_BAR;
            PG8_LDA(At, 0, 1); PG8_STAGE(PG8_SA(0, 0), a2, voffA);
            PG8_BAR; PG8_WAIT_L(0); PG8_MMA(1, 0, At, B0); PG8_BAR; PG8_SCHED;
            PG8_STAGE(PG8_SB(0, 1), b2 + hstep, voffB);
            PG8_WAIT_V(6); PG8_BAR; PG8_MMA(1, 1, At, B1); PG8_BAR;
            PG8_LDB(B0, 1, 0); PG8_SCHED; PG8_LDA(At, 1, 0); PG8_STAGE(PG8_SA(0, 1), a2 + hstepA, voffA);
            PG8_WAIT_L(8); PG8_BAR; PG8_WAIT_L(0); PG8_MMA(0, 0, At, B0); PG8_BAR; PG8_SCHED;
            PG8_LDB(B1, 1, 1); PG8_STAGE(PG8_SB(1, 0), b3, voffB);
            PG8_BAR; PG8_WAIT_L(0); PG8_MMA(0, 1, At, B1); PG8_BAR;
            PG8_LDA(At, 1, 1); PG8_STAGE(PG8_SA(1, 0), a3, voffA);
            PG8_BAR; PG8_WAIT_L(0); PG8_MMA(1, 0, At, B0); PG8_BAR; PG8_SCHED;
            PG8_STAGE(PG8_SB(1, 1), b3 + hstep, voffB);
            PG8_WAIT_V(6); PG8_BAR; PG8_MMA(1, 1, At, B1); PG8_BAR;
        }
        E(acc, cur, wr, wc, fr, fq);
        if (!has_next) break;
#pragma unroll
        for (int a = 0; a < 2; ++a)
#pragma unroll
            for (int b = 0; b < 2; ++b)
#pragma unroll
                for (int m = 0; m < 4; ++m)
#pragma unroll
                    for (int n = 0; n < 2; ++n) acc[a][b][m][n] = (f32x4){0.f, 0.f, 0.f, 0.f};
        cur = nxt; cA = nA; cB = nB; ++ui;
    }
    PG8_WAIT_V(0);
    if (wr == 0) PG8_BAR;
    PG8_BAR;
#undef PG8_SA
#undef PG8_SB
#undef PG8_STAGE
#undef PG8_LDA
#undef PG8_LDB
#undef PG8_MMA
#undef PG8_WAIT_V
#undef PG8_WAIT_L
#undef PG8_BAR
#undef PG8_SCHED
}
}

typedef f32x4 (&AccRef)[2][2][4][2];

struct EpiUp {
    static constexpr bool PERM = true, SPLIT = false, MID = false;
    bf16_t* Hm;
    DEVI void operator()(AccRef acc, const pg8::Unit& u, int wr, int wc, int fr, int fq) const {
        const int row0 = u.pm * 256 + wr * 64 + fr, col = u.pn * 128 + wc * 32 + 8 * fq;
#pragma unroll
        for (int ai = 0; ai < 2; ++ai)
#pragma unroll
            for (int m = 0; m < 4; ++m) { bf16_t* rowp = Hm + (size_t)(row0 + ai * 128 + m * 16) * DFF + col; float h[8];
#pragma unroll
                for (int j = 0; j < 8; ++j) { const float gt = acc[ai][0][m][j >> 2][j & 3], up = acc[ai][1][m][j >> 2][j & 3]; h[j] = gt * sigmoidf_(gt) * up; }
                u32x4 w; w.x = cvtpk(h[0], h[1]); w.y = cvtpk(h[2], h[3]); w.z = cvtpk(h[4], h[5]); w.w = cvtpk(h[6], h[7]); __builtin_nontemporal_store(w, (u32x4*)rowp); }
    }
};
struct EpiRes {
    static constexpr bool PERM = false, SPLIT = false, MID = false;
    const float* base; float* out; float alpha;
    DEVI void operator()(AccRef acc, const pg8::Unit& u, int wr, int wc, int fr, int fq) const {
        unsigned o = (unsigned)((u.pm * 256 + wr * 64 + fr) * DM + u.pn * 256 + wc * 32 + 4 * fq) * 4u;
        const bool lo = fr < 8;
        unsigned os = (unsigned)((u.pm * 256 + wr * 64 + (fr & 7)) * DM + u.pn * 256 + wc * 32 + 4 * fq) * 4u + (lo ? 0u : 64u);
#pragma unroll
        for (int ai = 0; ai < 2; ++ai) {
            asm volatile("" : "+v"(o), "+v"(os));
            f32x4 b[4][2][2];
#pragma unroll
            for (int m = 0; m < 4; ++m)
#pragma unroll
                for (int bj = 0; bj < 2; ++bj)
#pragma unroll
                    for (int n = 0; n < 2; ++n) b[m][bj][n] = *(const f32x4*)((const char*)base + o + (unsigned)(m * 16 * DM * 4 + bj * 512 + n * 64));
#pragma unroll
            for (int m = 0; m < 4; ++m)
#pragma unroll
                for (int bj = 0; bj < 2; ++bj) { const f32x4 d0 = b[m][bj][0] + alpha * acc[ai][bj][m][0], d1 = b[m][bj][1] + alpha * acc[ai][bj][m][1];
                    f32x4 t0, t1;
#pragma unroll
                    for (int i = 0; i < 4; ++i) { t0[i] = dpp<0x128>(d0[i]); t1[i] = dpp<0x128>(d1[i]); }
                    const f32x4 sa = lo ? d0 : t1, sb = lo ? t0 : d1;
                    const unsigned oo = os + (unsigned)(m * 16 * DM * 4 + bj * 512);
                    *(f32x4*)((char*)out + oo) = sa; *(f32x4*)((char*)out + oo + 8u * DM * 4u) = sb; }
            o += 128u * DM * 4u; os += 128u * DM * 4u; }
    }
};
struct EpiInProj {
    static constexpr bool PERM = true, SPLIT = false, MID = false;
    unsigned char* ws; const float* bias; const float* qg; const float* kg; float* Pt;
    DEVI void operator()(AccRef acc, const pg8::Unit& u, int wr, int wc, int fr, int fq) const {
        const int sel = u.pn >> 2; bf16_t* dst = (bf16_t*)(ws + (size_t)(sel + 1) * UNIT);
        const int row0 = u.pm * 256 + wr * 64 + fr, col0 = (u.pn & 3) * 256 + wc * 32 + 8 * fq, bcol0 = u.pn * 256 + wc * 32 + 8 * fq + (u.pn >= 12 ? 8 : 0);
#pragma unroll
        for (int bj = 0; bj < 2; ++bj)
#pragma unroll
            for (int n = 0; n < 2; ++n) { const f32x4 bv = *(const f32x4*)(bias + bcol0 + bj * 128 + n * 4);
#pragma unroll
                for (int ai = 0; ai < 2; ++ai)
#pragma unroll
                    for (int m = 0; m < 4; ++m) acc[ai][bj][m][n] += bv; }
        if (u.pn < 8) {
#pragma unroll
            for (int ai = 0; ai < 2; ++ai)
#pragma unroll
                for (int m = 0; m < 4; ++m)
#pragma unroll
                    for (int bj = 0; bj < 2; ++bj) { const f32x4 a = acc[ai][bj][m][0], b = acc[ai][bj][m][1];
                        float s = (a[0] * a[0] + a[1] * a[1]) + (a[2] * a[2] + a[3] * a[3]) + (b[0] * b[0] + b[1] * b[1]) + (b[2] * b[2] + b[3] * b[3]);
                        s = xrow16_sum(s);
                        if (fq == 0) Pt[((ai * 128 + wr * 64 + m * 16 + fr) * 2 + bj) * 4 + wc] = s; }
            asm volatile("s_waitcnt lgkmcnt(0)" ::: "memory"); __builtin_amdgcn_s_barrier(); asm volatile("" ::: "memory");
            const float* gsrc = (u.pn < 4 ? qg : kg) + wc * 32 + 8 * fq; const f32x4 g0 = *(const f32x4*)gsrc, g1 = *(const f32x4*)(gsrc + 4);
#pragma unroll
            for (int ai = 0; ai < 2; ++ai)
#pragma unroll
                for (int m = 0; m < 4; ++m)
#pragma unroll
                    for (int bj = 0; bj < 2; ++bj) { const f32x4 p = *(const f32x4*)(Pt + ((ai * 128 + wr * 64 + m * 16 + fr) * 2 + bj) * 4);
                        const float rstd = __builtin_amdgcn_rsqf(((p[0] + p[1]) + (p[2] + p[3])) * (1.f / 128.f) + 1e-6f);
                        acc[ai][bj][m][0] *= g0 * rstd; acc[ai][bj][m][1] *= g1 * rstd; }
        }
#pragma unroll
        for (int ai = 0; ai < 2; ++ai)
#pragma unroll
            for (int m = 0; m < 4; ++m) { bf16_t* rowp = dst + (size_t)(row0 + ai * 128 + m * 16) * DM + col0;
#pragma unroll
                for (int bj = 0; bj < 2; ++bj) { const f32x4 v0 = acc[ai][bj][m][0], v1 = acc[ai][bj][m][1];
                    u32x4 w; w.x = cvtpk(v0[0], v0[1]); w.y = cvtpk(v0[2], v0[3]); w.z = cvtpk(v1[0], v1[1]); w.w = cvtpk(v1[2], v1[3]); __builtin_nontemporal_store(w, (u32x4*)(rowp + bj * 128)); } }
    }
};
struct EpiMergeF {
    static constexpr bool PERM = true, SPLIT = true, MID = true;
    const bf16_t* gA; const bf16_t* gR; bf16_t* out;
    DEVI void mid(AccRef acc, const pg8::Unit& u, int wr, int wc, int fr, int fq) const {
        unsigned o = (unsigned)((u.pm * 256 + wr * 64 + fr) * DM + u.pn * 256 + wc * 32 + 8 * fq) * 2u;
#pragma unroll
        for (int ai = 0; ai < 2; ++ai) {
            asm volatile("" : "+v"(o));
            u32x4 ga[4][2], gr[4][2];
#pragma unroll
            for (int m = 0; m < 4; ++m)
#pragma unroll
                for (int bj = 0; bj < 2; ++bj) { ga[m][bj] = *(const u32x4*)((const char*)gA + o + (unsigned)(m * 16 * DM * 2 + bj * 256)); gr[m][bj] = *(const u32x4*)((const char*)gR + o + (unsigned)(m * 16 * DM * 2 + bj * 256)); }
#pragma unroll
            for (int m = 0; m < 4; ++m)
#pragma unroll
                for (int bj = 0; bj < 2; ++bj) { const u32x4 a = ga[m][bj], r = gr[m][bj];
                    const float av[8] = {bflo(a.x), bfhi(a.x), bflo(a.y), bfhi(a.y), bflo(a.z), bfhi(a.z), bflo(a.w), bfhi(a.w)};
                    const float rv[8] = {bflo(r.x), bfhi(r.x), bflo(r.y), bfhi(r.y), bflo(r.z), bfhi(r.z), bflo(r.w), bfhi(r.w)};
#pragma unroll
                    for (int j = 0; j < 8; ++j) { const float q = (1.f + __expf(-rv[j])) * __builtin_amdgcn_rcpf(1.f + __expf(-av[j])); acc[ai][bj][m][j >> 2][j & 3] *= q; } }
            o += 128u * DM * 2u; }
    }
    DEVI void operator()(AccRef acc, const pg8::Unit& u, int wr, int wc, int fr, int fq) const {
        unsigned o = (unsigned)((u.pm * 256 + wr * 64 + fr) * DM + u.pn * 256 + wc * 32 + 8 * fq) * 2u;
#pragma unroll
        for (int ai = 0; ai < 2; ++ai) {
            asm volatile("" : "+v"(o));
            u32x4 gr[4][2];
#pragma unroll
            for (int m = 0; m < 4; ++m)
#pragma unroll
                for (int bj = 0; bj < 2; ++bj) gr[m][bj] = *(const u32x4*)((const char*)gR + o + (unsigned)(m * 16 * DM * 2 + bj * 256));
#pragma unroll
            for (int m = 0; m < 4; ++m)
#pragma unroll
                for (int bj = 0; bj < 2; ++bj) { const u32x4 r = gr[m][bj];
                    const float rv[8] = {bflo(r.x), bfhi(r.x), bflo(r.y), bfhi(r.y), bflo(r.z), bfhi(r.z), bflo(r.w), bfhi(r.w)}; float v[8];
#pragma unroll
                    for (int j = 0; j < 8; ++j) v[j] = acc[ai][bj][m][j >> 2][j & 3] * sigmoidf_(rv[j]);
                    u32x4 w; w.x = cvtpk(v[0], v[1]); w.y = cvtpk(v[2], v[3]); w.z = cvtpk(v[4], v[5]); w.w = cvtpk(v[6], v[7]); *(u32x4*)((char*)out + o + (unsigned)(m * 16 * DM * 2 + bj * 256)) = w; }
            o += 128u * DM * 2u; }
    }
};

namespace att {
constexpr float SCALE = 0.08838834764831845f;
constexpr int NW = 8, QBLK = 32, KVBLK = 64, QB = NW * QBLK, D = 128, RS = 1024;
constexpr int SHM_V = KVBLK * D * 2, SHM_K = KVBLK * D * 2;
constexpr int OFF_WS = 2 * SHM_V + 2 * SHM_K, OFF_BIAS = OFF_WS + NW * 64 * 4;
constexpr float THR = 8.f;
constexpr unsigned WBIG = 0x40000000u;
#define KSWZ(row, colB) ((row) * 256 + ((colB) ^ (((row) & 7) << 4)))
#define SBAR() __builtin_amdgcn_sched_barrier(0)
DEVI int v_st(int k, int c) { const int kk = (k & ~0xC) | ((k & 4) << 1) | ((k & 8) >> 1); return ((kk >> 3) * 4 + (c >> 5)) * 512 + ((kk & 7) * 32 + (c & 31)) * 2; }
DEVI int v_rd_base(int lane) { return ((lane & 3) << 3) | (((lane >> 2) & 3) << 6) | (((lane >> 4) & 1) << 5) | (((lane >> 5) & 1) << 8); }
constexpr int v_rd_off(int d0, int ks, int half) { return d0 * 512 + ks * 4096 + half * 2048; }
DEVI int crow(int r, int hi) { return (r & 3) + 8 * (r >> 2) + 4 * hi; }
DEVI bf16x8 ld8(const bf16_t* p) { return *reinterpret_cast<const bf16x8*>(p); }
DEVI void mask_tile(f32x16& p0, f32x16& p1, int dq, unsigned W) {
    const float NEG = -__builtin_inff();
#pragma unroll
    for (int r = 0; r < 16; ++r) {
        const int c = (r & 3) + 8 * (r >> 2);
        if ((unsigned)(dq - c) >= W) p0[r] = NEG;
        if ((unsigned)(dq - c - 32) >= W) p1[r] = NEG;
    }
}
DEVI void partialSM(f32x16& p0, f32x16& p1, float& m_reg, float& mn, float& alpha) {
    float pmax = p0[0]; for (int r = 1; r < 16; ++r) pmax = fmaxf(pmax, p0[r]); for (int r = 0; r < 16; ++r) pmax = fmaxf(pmax, p1[r]);
    { auto rr = __builtin_amdgcn_permlane32_swap(__float_as_uint(pmax), __float_as_uint(pmax), false, false);
      pmax = fmaxf(__uint_as_float(rr[0]), __uint_as_float(rr[1])); }
    constexpr float C2 = 1.4426950408889634f * SCALE;
    if (__builtin_expect(__all((pmax - m_reg) * SCALE <= THR), 1)) { mn = m_reg; alpha = 1.f; }
    else { mn = fmaxf(m_reg, pmax); alpha = __builtin_amdgcn_exp2f((m_reg - mn) * C2); m_reg = mn; }
    const float mnL = -mn * C2;
    for (int r = 0; r < 16; ++r) p0[r] = fmaf(p0[r], C2, mnL); for (int r = 0; r < 16; ++r) p1[r] = fmaf(p1[r], C2, mnL);
    for (int r = 0; r < 16; ++r) p0[r] = __builtin_amdgcn_exp2f(p0[r]);
}
DEVI void finishSM(f32x16& p0, f32x16& p1, float alpha, float& l_reg, bf16x8& pa0, bf16x8& pa1, bf16x8& pa2, bf16x8& pa3) {
    for (int r = 0; r < 16; ++r) p1[r] = __builtin_amdgcn_exp2f(p1[r]);
    float ps = 0; for (int r = 0; r < 16; ++r) ps += p0[r]; for (int r = 0; r < 16; ++r) ps += p1[r];
    { auto rr = __builtin_amdgcn_permlane32_swap(__float_as_uint(ps), __float_as_uint(ps), false, false);
      ps = __uint_as_float(rr[0]) + __uint_as_float(rr[1]); }
    l_reg = l_reg * alpha + ps;
#define PK4(P, B_, OUT) do { unsigned a0 = cvtpk(P[B_+0], P[B_+1]), a1 = cvtpk(P[B_+2], P[B_+3]);                          \
        unsigned b0 = cvtpk(P[B_+4], P[B_+5]), b1 = cvtpk(P[B_+6], P[B_+7]);                                             \
        auto r0 = __builtin_amdgcn_permlane32_swap(a0, b0, false, false); auto r1 = __builtin_amdgcn_permlane32_swap(a1, b1, false, false); \
        u32x4 w = {r0[0], r1[0], r0[1], r1[1]}; OUT = *reinterpret_cast<bf16x8*>(&w); } while (0)
    PK4(p0, 0, pa0); PK4(p0, 8, pa1); PK4(p1, 0, pa2); PK4(p1, 8, pa3);
#undef PK4
}
template <int KB>
DEVI void qkt(f32x16& p0, f32x16& p1, const char* K_lds, const char* biasb0, int r32, int hi, const bf16x8* qr) {
    int hb_ = hi * 16; asm volatile("" : "+v"(hb_)); const char* biasb = biasb0 + hb_;
#pragma unroll
    for (int g = 0; g < 4; ++g) { const f32x4 b0 = *(const f32x4*)(biasb + KB * 256 + g * 32), b1 = *(const f32x4*)(biasb + KB * 256 + 128 + g * 32);
#pragma unroll
        for (int i = 0; i < 4; ++i) { p0[4 * g + i] = b0[i]; p1[4 * g + i] = b1[i]; } }
    const char* kb[4];
#pragma unroll
    for (int dd = 0; dd < 4; ++dd) kb[dd] = K_lds + KB * SHM_K + KSWZ(r32, (dd * 16 + hi * 8) * 2);
#pragma unroll
    for (int d0 = 0; d0 < 8; ++d0) { const char* a = kb[d0 & 3] + (d0 >> 2) * 128;
        bf16x8 b0 = *reinterpret_cast<const bf16x8*>(a);
        bf16x8 b1 = *reinterpret_cast<const bf16x8*>(a + 32 * 256);
        p0 = __builtin_amdgcn_mfma_f32_32x32x16_bf16(b0, qr[d0], p0, 0, 0, 0);
        p1 = __builtin_amdgcn_mfma_f32_32x32x16_bf16(b1, qr[d0], p1, 0, 0, 0); }
}
template <int VB>
DEVI void pv_tile(f32x16* o, int vb0, bf16x8 pa0, bf16x8 pa1, bf16x8 pa2, bf16x8 pa3) {
#define TRRD(dst, off) asm volatile("ds_read_b64_tr_b16 %0, %1 offset:%2" : "=&v"(dst) : "v"(vb0), "i"(off) : "memory")
#define PV_D0(d0) do { s16x4 l0, l1, l2, l3, h0, h1, h2, h3; constexpr int b_ = VB * SHM_V + v_rd_off(d0, 0, 0); \
        TRRD(l0, b_); TRRD(h0, b_ + 2048); TRRD(l1, b_ + 4096); TRRD(h1, b_ + 6144); TRRD(l2, b_ + 8192); TRRD(h2, b_ + 10240); TRRD(l3, b_ + 12288); TRRD(h3, b_ + 14336); \
        asm volatile("s_waitcnt lgkmcnt(0)" ::: "memory"); SBAR();   \
        o[d0] = __builtin_amdgcn_mfma_f32_32x32x16_bf16(pa0, (bf16x8){l0[0], l0[1], l0[2], l0[3], h0[0], h0[1], h0[2], h0[3]}, o[d0], 0, 0, 0);   \
        o[d0] = __builtin_amdgcn_mfma_f32_32x32x16_bf16(pa1, (bf16x8){l1[0], l1[1], l1[2], l1[3], h1[0], h1[1], h1[2], h1[3]}, o[d0], 0, 0, 0);   \
        o[d0] = __builtin_amdgcn_mfma_f32_32x32x16_bf16(pa2, (bf16x8){l2[0], l2[1], l2[2], l2[3], h2[0], h2[1], h2[2], h2[3]}, o[d0], 0, 0, 0);   \
        o[d0] = __builtin_amdgcn_mfma_f32_32x32x16_bf16(pa3, (bf16x8){l3[0], l3[1], l3[2], l3[3], h3[0], h3[1], h3[2], h3[3]}, o[d0], 0, 0, 0); } while (0)
    PV_D0(0); PV_D0(1); PV_D0(2); PV_D0(3);
#undef PV_D0
#undef TRRD
}
struct BlockRef { const bf16_t* Q; const bf16_t* K; const bf16_t* V; bf16_t* O; const float* C; int P0; int jlo; };
struct Seam { bf16x8 qr[8]; bf16x8 st_v0, st_v1, st_k0, st_k1; };
#define ROW(p, k0, rr) ((p) + (size_t)((k0) + (rr)) * RS + sc)
#define VMW() asm volatile("s_waitcnt vmcnt(0)" ::: "memory")
#define VMWN(n) asm volatile("s_waitcnt vmcnt(%0)" :: "i"(n) : "memory")
#define SLOAD_H(Kp, Vp, Cp, k0, bf) do { S.st_v0 = ld8(ROW(Vp, k0, sr)); S.st_v1 = ld8(ROW(Vp, k0, 32 + sr));              \
                         S.st_k0 = ld8(ROW(Kp, k0, sr)); S.st_k1 = ld8(ROW(Kp, k0, 32 + sr));                                 \
                         if (wid == 0) __builtin_amdgcn_global_load_lds((const unsigned*)((Cp) + (k0) + lane), (PG8_LAS unsigned*)(biasD + (bf) * 256), 4, 0, 0); } while (0)
#define SWRITE_HK(bf) do { *(bf16x8*)(K_lds + (bf) * SHM_K + kws) = S.st_k0; *(bf16x8*)(K_lds + (bf) * SHM_K + kws + 32 * 256) = S.st_k1; } while (0)
#define SWRITE_HV(bf) do { *(bf16x8*)(V_lds + (bf) * SHM_V + vst0) = S.st_v0; *(bf16x8*)(V_lds + (bf) * SHM_V + vst1) = S.st_v1; } while (0)
#define SWRITE_H(bf) do { SWRITE_HV(bf); SWRITE_HK(bf); } while (0)
DEVI void prime(const BlockRef& cur, char* lds, Seam& S, int wv) {
    const int tid = ltid(wv), wid = __builtin_amdgcn_readfirstlane(tid >> 6), lane = tid & 63, r32 = lane & 31, hi = lane >> 5;
    const int sr = tid >> 4, sc = (tid & 15) * 8, kws = KSWZ(sr, sc * 2); char* K_lds = lds + 2 * SHM_V; PG8_LAS unsigned char* biasD = (PG8_LAS unsigned char*)(lds + OFF_BIAS);
    const int kb0 = (cur.P0 / KVBLK + QB / KVBLK - 1) * KVBLK;
    for (int d0 = 0; d0 < 8; ++d0) S.qr[d0] = ld8(cur.Q + (size_t)(wid * QBLK + r32) * RS + d0 * 16 + hi * 8);
    SLOAD_H(cur.K, cur.V, cur.C, kb0, 0); VMW(); SWRITE_HK(0);
    __syncthreads();
}
DEVI void block(const BlockRef& cur, const BlockRef& nxt, char* lds, Seam& S, int wv) {
    const int tid = ltid(wv), wid = __builtin_amdgcn_readfirstlane(tid >> 6), lane = tid & 63, r32 = lane & 31, hi = lane >> 5;
    const int j_lo = cur.jlo;
    const int j_hi = (cur.P0 + QB - 1) / KVBLK + 1;
    const int NT = j_hi - j_lo;
    const int kbn = (nxt.P0 / KVBLK + QB / KVBLK - 1) * KVBLK;
    const int qlo = cur.P0 + wid * QBLK, qm = qlo + r32 - 4 * hi;
    char* V_lds = lds; char* K_lds = lds + 2 * SHM_V;
    float* ws = (float*)(lds + OFF_WS) + wid * 64; float* li_l = ws, * al_l = ws + 32;
    PG8_LAS unsigned char* biasD = (PG8_LAS unsigned char*)(lds + OFF_BIAS); const char* biasb = lds + OFF_BIAS;
    float m_reg = -1e30f, l_reg = 0; f32x16 o[4] = {};
    const int sr = tid >> 4, sc = (tid & 15) * 8, vst0 = v_st(sr, sc), vst1 = v_st(32 + sr, sc), kws = KSWZ(sr, sc * 2);
    const int vb0 = (int)(uintptr_t)V_lds + v_rd_base(lane);
    const bf16_t* Kh = cur.K; const bf16_t* Vh = cur.V; const float* Ch = cur.C;
#define RESC(a) do { if (__any((a) < 1.f)) { if (hi == 0) al_l[r32] = (a); asm volatile("s_waitcnt lgkmcnt(0)" ::: "memory");              \
                     for (int d_ = 0; d_ < 4; ++d_) for (int r = 0; r < 16; ++r) o[d_][r] *= al_l[crow(r, hi)]; } } while (0)
#define KBASE(t) ((j_hi - 1 - (t)) * KVBLK)
#define MASKT(P0_, P1_, t) do { const int kb_ = KBASE(t); if (kb_ + KVBLK - 1 > qlo) mask_tile(P0_, P1_, qm - kb_, WBIG); } while (0)
    constexpr int NQL = 8;
#define SEAM_K0() do { VMWN(NQL); SWRITE_HK(0); SBAR(); } while (0)
    f32x16 pA0, pA1, pB0, pB1; float mnA, mnB, alA, alB; bf16x8 pa0, pa1, pa2, pa3;
    SWRITE_HV(0); SBAR();
    if (NT > 1) { SLOAD_H(Kh, Vh, Ch, KBASE(1), 1); }
    SBAR(); qkt<0>(pA0, pA1, K_lds, biasb, r32, hi, S.qr);
    MASKT(pA0, pA1, 0); partialSM(pA0, pA1, m_reg, mnA, alA);
    if (NT > 1) { VMW(); SWRITE_H(1); }
    __syncthreads();
#define HALF_STEP(PX0, PX1, mnX, alX, PY0, PY1, alY, t, KB, VB, SB) do {                                                      \
        SBAR(); qkt<KB>(PX0, PX1, K_lds, biasb, r32, hi, S.qr);                                             \
        finishSM(PY0, PY1, alY, l_reg, pa0, pa1, pa2, pa3); SBAR();                                                           \
        if ((t) + 1 < NT) { SLOAD_H(Kh, Vh, Ch, KBASE((t) + 1), SB); SBAR(); }                                               \
        pv_tile<VB>(o, vb0, pa0, pa1, pa2, pa3); MASKT(PX0, PX1, (t)); partialSM(PX0, PX1, m_reg, mnX, alX);                                        \
        __syncthreads();                                                                                                      \
        if ((t) + 1 < NT) { VMW(); SWRITE_H(SB); }                                                                          \
        RESC(alX); __syncthreads(); } while (0)
    for (int t = 1; t + 1 < NT; t += 2) {
        HALF_STEP(pB0, pB1, mnB, alB, pA0, pA1, alA, t, 1, 0, 0);
        HALF_STEP(pA0, pA1, mnA, alA, pB0, pB1, alB, t + 1, 0, 1, 1);
    }
    const bool even = (NT & 1) == 0;
    if (even) { SBAR(); qkt<1>(pB0, pB1, K_lds, biasb, r32, hi, S.qr); SBAR(); }
    SLOAD_H(nxt.K, nxt.V, nxt.C, kbn, 0); SBAR();
#pragma unroll
    for (int d0 = 0; d0 < 8; ++d0) S.qr[d0] = ld8(nxt.Q + (size_t)(wid * QBLK + r32) * RS + d0 * 16 + hi * 8);
    SBAR();
    finishSM(pA0, pA1, alA, l_reg, pa0, pa1, pa2, pa3); SBAR();
    pv_tile<0>(o, vb0, pa0, pa1, pa2, pa3);
    if (even) { MASKT(pB0, pB1, NT - 1); partialSM(pB0, pB1, m_reg, mnB, alB); __syncthreads(); RESC(alB);
        finishSM(pB0, pB1, alB, l_reg, pa0, pa1, pa2, pa3); SBAR(); pv_tile<1>(o, vb0, pa0, pa1, pa2, pa3); }
    SBAR(); SEAM_K0();
    if (hi == 0) li_l[r32] = l_reg; asm volatile("s_waitcnt lgkmcnt(0)" ::: "memory");
    float rli[16];
#pragma unroll
    for (int r = 0; r < 16; ++r) rli[r] = __builtin_amdgcn_rcpf(li_l[crow(r, hi)]);
    bf16_t* Ow = cur.O + (size_t)(wid * QBLK) * RS;
#pragma unroll
    for (int r = 0; r < 16; ++r) { const int orow = crow(r, hi);
#pragma unroll
        for (int d0 = 0; d0 < 4; ++d0) { const float v = o[d0][r] * rli[r];
            const float vn = dpp<0xB1>(v);
            if ((r32 & 1) == 0) *(unsigned*)(Ow + (size_t)orow * RS + d0 * 32 + r32) = cvtpk(v, vn); } }
    __syncthreads();
#undef RESC
#undef KBASE
#undef MASKT
#undef SEAM_K0
#undef HALF_STEP
}
#undef ROW
#undef VMW
#undef VMWN
#undef SLOAD_H
#undef SWRITE_HK
#undef SWRITE_HV
#undef SWRITE_H
DEVI BlockRef mkref(int L, const bf16_t* Qb, const bf16_t* Kb, const bf16_t* Vb, bf16_t* Ob, const float* cs, const int* jlo) {
    BlockRef r; const int bh = L >> 6, qb = L & 63, b = bh >> 3, h = bh & 7;
    const size_t base = ((size_t)b * SEQ + (size_t)qb * QB) * RS + h * D, kvb = (size_t)b * SEQ * RS + h * D;
    r.Q = Qb + base; r.O = Ob + base; r.K = Kb + kvb; r.V = Vb + kvb; r.C = cs + (size_t)bh * SEQ; r.P0 = qb * QB; r.jlo = jlo[L];
    return r;
}
DEVI void phase(const bf16_t* Qb, const bf16_t* Kb, const bf16_t* Vb, bf16_t* Ob, const float* cs, const int* jlo, char* lds, int wv) {
    const int total = 16 * 64, stride = lgrid();
    const int bid_ = lbid();
    int L = (stride % 8 == 0) ? (bid_ % 8) * (stride / 8) + bid_ / 8 : bid_; if (L >= total) return;
    BlockRef cur = mkref(L, Qb, Kb, Vb, Ob, cs, jlo);
    Seam S;
    prime(cur, lds, S, wv);
    for (;;) {
        const bool last = L + stride >= total; const int Ln = last ? L : L + stride;
        const BlockRef nxt = last ? cur : mkref(Ln, Qb, Kb, Vb, Ob, cs, jlo);
        block(cur, nxt, lds, S, wv);
        if (last) break;
        cur = nxt; L = Ln;
    }
}
}

DEVI void norm_phase(const float* __restrict__ x, const float* __restrict__ gain, bf16_t* __restrict__ out,
                     const float* wf_src, const float* bf_src, float* logf, char* lds, int wv) {
    const int tid = ltid(wv), lane = tid & 63, wave = tid >> 6;
    float* wf = (float*)lds;
    if (wf_src) {
        for (int e = tid; e < 8192; e += 512) { const int k = e >> 3, h = e & 7; wf[h * 1024 + k] = wf_src[(size_t)k * NIN + 3072 + h]; }
        __syncthreads();
    }
    f32x4 g[4];
#pragma unroll
    for (int j = 0; j < 4; ++j) g[j] = *(const f32x4*)(gain + j * 256 + lane * 4);
    const int nw = lgrid() * 8;
    for (int row0 = lbid() * 8 + wave; row0 < T_TOK; row0 += 2 * nw) {
        f32x4 v[2][4]; float ss[2];
#pragma unroll
        for (int q = 0; q < 2; ++q) { const int row = row0 + q * nw < T_TOK ? row0 + q * nw : row0; const float* xr = x + (size_t)row * DM;
#pragma unroll
            for (int j = 0; j < 4; ++j) v[q][j] = *(const f32x4*)(xr + j * 256 + lane * 4); }
#pragma unroll
        for (int q = 0; q < 2; ++q) { float s_ = 0.f;
#pragma unroll
            for (int j = 0; j < 4; ++j) s_ += v[q][j][0] * v[q][j][0] + v[q][j][1] * v[q][j][1] + v[q][j][2] * v[q][j][2] + v[q][j][3] * v[q][j][3];
            ss[q] = wave_sum(s_); }
#pragma unroll
        for (int q = 0; q < 2; ++q) { const int row = row0 + q * nw; if (row >= T_TOK) break;
            const float rstd = __builtin_amdgcn_rsqf(ss[q] * (1.f / 1024.f) + 1e-6f);
#pragma unroll
            for (int j = 0; j < 4; ++j) { v[q][j] = v[q][j] * rstd * g[j]; u32x2 w; w.x = cvtpk(v[q][j][0], v[q][j][1]); w.y = cvtpk(v[q][j][2], v[q][j][3]); *(u32x2*)(out + (size_t)row * DM + j * 256 + lane * 4) = w; }
            if (wf_src) {
                float z = 0.f;
#pragma unroll
                for (int h = 0; h < 8; ++h) { float d = 0.f;
#pragma unroll
                    for (int j = 0; j < 4; ++j) { const f32x4 w = *(const f32x4*)(wf + h * 1024 + j * 256 + lane * 4); d += v[q][j][0] * w[0] + v[q][j][1] * w[1] + v[q][j][2] * w[2] + v[q][j][3] * w[3]; }
                    d = wave_sum(d); if (lane == h) z = d; }
                if (lane < 8) { z += bf_src[lane]; logf[((size_t)(row >> 14) * 8 + lane) * SEQ + (row & (SEQ - 1))] = fminf(z, 0.f) - __logf(1.f + __expf(-fabsf(z))); }
            }
        }
    }
    __syncthreads();
}

template <int KT, class F> DEVI void cvt_tile(F colptr, int ldsrc, int k0, bf16_t* out, int ldo, int v0, float* tile, int wv) {
    const int tid = ltid(wv);
    constexpr int PITCH = KT * 64 + 1;
    { const int vc = tid & 63, kk = tid >> 6; const float* cp = colptr(v0 + vc) + (size_t)k0 * ldsrc; float v[8 * KT];
#pragma unroll
      for (int r = 0; r < 8 * KT; ++r) v[r] = cp[(size_t)(r * 8 + kk) * ldsrc];
#pragma unroll
      for (int r = 0; r < 8 * KT; ++r) tile[vc * PITCH + r * 8 + kk] = v[r]; }
    __syncthreads();
    { const int vc = tid >> 3, k8 = (tid & 7) * 8;
#pragma unroll
      for (int q = 0; q < KT; ++q) { const float* tp = tile + vc * PITCH + q * 64 + k8;
        u32x4 w = {cvtpk(tp[0], tp[1]), cvtpk(tp[2], tp[3]), cvtpk(tp[4], tp[5]), cvtpk(tp[6], tp[7])};
        *(u32x4*)(out + (size_t)(v0 + vc) * ldo + k0 + q * 64 + k8) = w; } }
    __syncthreads();
}
struct ColGU { const float* wg; long du; DEVI const float* operator()(int v) const { return (const float*)((const char*)wg + (((v >> 7) & 1) ? du : 0l)) + (v >> 8) * 128 + (v & 127); } };
struct ColLin { const float* w; DEVI const float* operator()(int v) const { return w + v; } };
struct ColIn { const float* w; DEVI const float* operator()(int v) const { return w + (v < 3072 ? v : v + 8); } };
DEVI void cvt_ffn_phase(const float* wg, const float* wu, const float* wd, unsigned char* ws, char* lds, int j0, int jstride, int wv) {
    float* tile = (float*)(lds + 32768);
    bf16_t* Wgu = (bf16_t*)(ws + FFW_GU); bf16_t* Wd = (bf16_t*)(ws + FFW_D);
    for (int job = j0; job < 352 + 176; job += jstride) {
        if (job < 352) { const int vt = job >> 2, kg = job & 3; cvt_tile<4>(ColGU{wg, (long)((const char*)wu - (const char*)wg)}, DFF, kg * 256, Wgu, DM, vt * 64, tile, wv); }
        else { const int j = job - 352, vt = j / 11, kg = j % 11; cvt_tile<4>(ColLin{wd}, DM, kg * 256, Wd, DFF, vt * 64, tile, wv); }
    }
}
DEVI void cvt_mix_phase(const float* win, const float* woa, const float* wor, const float* wout, const float* lwa, const float* lwx, unsigned char* ws, char* lds, int wv) {
    float* tile = (float*)(lds + 32768);
    for (int job = lbid(); job < 448 + 192 + 32; job += lgrid()) {
        if (job < 448) { const int vt = job >> 2, kg = job & 3; cvt_tile<4>(ColIn{win}, NIN, kg * 256, (bf16_t*)(ws + WS_WIN), DM, vt * 64, tile, wv); }
        else if (job < 448 + 192) { const int j = job - 448, m = j >> 6, jj = j & 63, vt = jj >> 2, kg = jj & 3;
            const float* src = m == 0 ? woa : (m == 1 ? wor : wout);
            if (m < 2) cvt_tile<4>(ColLin{src}, DM, kg * 256, (bf16_t*)(ws + WS_WOA) + m * DM, 2 * DM, vt * 64, tile, wv);
            else cvt_tile<4>(ColLin{src}, DM, kg * 256, (bf16_t*)(ws + WS_WOUT), DM, vt * 64, tile, wv); }
        else { const int j = job - 448 - 192, gate = j >> 4, n = j & 15; const float* src = (gate ? lwx : lwa) + n * 4096;
            cvt_tile<1>(ColLin{src}, 64, 0, (bf16_t*)(ws + WS_LRU) + n * 8192 + gate * 4096, 64, 0, tile, wv); }
    }
}

DEVI void post_inproj_phase(const float* logf, float* cs, int* jlo, const float* qg, const float* kg, bf16_t* Qb, bf16_t* Kb, char* lds, int wv) {
    const int tid = ltid(wv), lane = tid & 63, wave = tid >> 6;
    if (lbid() < 16) {
        const int bh = lbid(), b = bh >> 3, h = bh & 7;
#define PADI(e) ((e) + ((e) >> 5))
        float* cL = (float*)lds;
        double* wt = (double*)(lds + 69632);
        float* sm = (float*)(lds + 69632 + 64);
        const float* lf = logf + (size_t)bh * SEQ + (size_t)tid * 32;
        float vals[32]; double tot = 0.0;
#pragma unroll
        for (int i = 0; i < 32; i += 4) { const f32x4 v4 = *(const f32x4*)(lf + i); vals[i] = v4[0]; vals[i + 1] = v4[1]; vals[i + 2] = v4[2]; vals[i + 3] = v4[3]; }
#pragma unroll
        for (int i = 0; i < 32; ++i) tot += (double)vals[i];
        double* dt = (double*)(lds + 69632 + 128);
        double* g1 = dt + 512;
        double* g2 = g1 + 64;
        dt[tid] = tot;
        if (wave == 0) { float gq = fmaxf(fabsf(qg[lane]), fabsf(qg[lane + 64])), gk = fmaxf(fabsf(kg[lane]), fabsf(kg[lane + 64]));
            gq = wave_max(gq); gk = wave_max(gk);
            if (lane == 0) sm[0] = 2.f * 11.313708499f * gq * gk; }
        __syncthreads();
        if (tid < 64) { double a_ = 0.0;
#pragma unroll
            for (int i = 0; i < 8; ++i) a_ += dt[tid * 8 + i];
            g1[tid] = a_; }
        __syncthreads();
        if (tid < 8) { double a_ = 0.0;
#pragma unroll
            for (int i = 0; i < 8; ++i) a_ += g1[tid * 8 + i];
            g2[tid] = a_; }
        __syncthreads();
        double run = 0.0;
        { const int t2 = tid >> 6, t1 = (tid >> 3) & 7, t0 = tid & 7;
#pragma unroll
          for (int j = 0; j < 7; ++j) { const double a2 = g2[j], a1 = g1[t2 * 8 + j], a0 = dt[(tid >> 3) * 8 + j]; run += (j < t2 ? a2 : 0.0) + (j < t1 ? a1 : 0.0) + (j < t0 ? a0 : 0.0); } }
#pragma unroll
        for (int i = 0; i < 32; ++i) { run += (double)vals[i]; cL[tid * 33 + i] = (float)run; }
        __syncthreads();
#pragma unroll 4
        for (int j = 0; j < 32; ++j) { const int e = j * 512 + tid; cs[(size_t)bh * SEQ + e] = -cL[PADI(e)] * 11.313708499f; }
        if (tid < 64) {
            const int P0 = tid * 256, nj = P0 / 64; const float cP = cL[PADI(P0)], thr = -(104.f + sm[0]);
            int lo = 0, hi = nj;
            while (lo < hi) { const int mid = (lo + hi) >> 1; if (cP - cL[PADI(64 * mid + 63)] >= thr) hi = mid; else lo = mid + 1; }
            jlo[bh * 64 + tid] = lo;
        }
        __syncthreads();
    }
}

DEVI void rnn_local_phase(const bf16_t* xr, const float* convw, const float* convb, const bf16_t* lruT, const float* ba, const float* bx, const float* lam,
                          bf16_t* hloc, bf16_t* pcum, float* aggA, float* aggH, char* lds, int wv) {
    const int tid = ltid(wv), lane = tid & 63, wave = __builtin_amdgcn_readfirstlane(tid >> 6);
    bf16_t* xcb = (bf16_t*)lds;
    float* xcf = (float*)(lds + 18432);
    float* aL = xcf + 128 * 65;
    float* uL = aL + 128 * 65;
    float* segA = uL + 128 * 65;
    float* segH = segA + 512;
    float* cwL = segH + 512;
    const int G = lgrid(), bid = lbid(), ns = G >> 4;
    if (ns == 0 || bid >= ns * 16) return;
    const int cb = bid & 15, slot = bid >> 4, ch0 = cb * 64;
    if (tid < 320) cwL[tid] = tid < 256 ? convw[(tid >> 6) * 1024 + ch0 + (tid & 63)] : convb[ch0 + (tid & 63)];
    const int l16 = lane & 15, q4 = lane >> 4;
    bf16_t* WtL = (bf16_t*)(cwL + 320);
    { const bf16_t* Wt = lruT + cb * 8192;
#pragma unroll
      for (int i = 0; i < 2; ++i) { const int e = tid + i * 512, r = e >> 3, c8 = (e & 7) * 8; *(u32x4*)(WtL + r * 72 + c8) = *(const u32x4*)(Wt + r * 64 + c8); } }
    float bav[4], bxv[4], sp8[4];
#pragma unroll
    for (int cg = 0; cg < 4; ++cg) { const int ch = cg * 16 + l16; bav[cg] = ba[ch0 + ch]; bxv[cg] = bx[ch0 + ch]; const float lm = lam[ch0 + ch];
        sp8[cg] = 8.f * (fmaxf(-lm, 0.f) + __logf(1.f + __expf(-fabsf(lm)))); }
    const int tok = tid >> 2, cg4 = (tid & 3) * 16;
    u32x4 xw[8];
#define RNN_LOAD(j_) do { const int b_ = (j_) >> 7, t0_ = ((j_) & 127) * 128; _Pragma("unroll") for (int k = 0; k < 4; ++k) { const int s_ = t0_ + tok - 3 + k; \
        const bf16_t* p_ = xr + ((size_t)b_ * SEQ + (s_ < 0 ? 0 : s_)) * DM + ch0 + cg4; xw[2 * k] = *(const u32x4*)p_; xw[2 * k + 1] = *(const u32x4*)(p_ + 8); } } while (0)
#define LBAR() do { asm volatile("s_waitcnt lgkmcnt(0)" ::: "memory"); __builtin_amdgcn_s_barrier(); asm volatile("" ::: "memory"); } while (0)
    int j = slot;
    if (j < 256) RNN_LOAD(j);
    __syncthreads();
    for (; j < 256; j += ns) {
        const int b = j >> 7, chunk = j & 127, t0 = chunk * 128;
        {
            float xc[16];
#pragma unroll
            for (int i = 0; i < 16; i += 4) { const f32x4 bb = *(const f32x4*)(cwL + 256 + cg4 + i); xc[i] = bb[0]; xc[i + 1] = bb[1]; xc[i + 2] = bb[2]; xc[i + 3] = bb[3]; }
#pragma unroll
            for (int k = 0; k < 4; ++k) { const float zf = (t0 + tok - 3 + k) >= 0 ? 1.f : 0.f; const u32x4 w0 = xw[2 * k], w1 = xw[2 * k + 1];
                const float xv[16] = {bflo(w0.x), bfhi(w0.x), bflo(w0.y), bfhi(w0.y), bflo(w0.z), bfhi(w0.z), bflo(w0.w), bfhi(w0.w), bflo(w1.x), bfhi(w1.x), bflo(w1.y), bfhi(w1.y), bflo(w1.z), bfhi(w1.z), bflo(w1.w), bfhi(w1.w)};
#pragma unroll
                for (int i = 0; i < 16; i += 4) { const f32x4 cw = *(const f32x4*)(cwL + k * 64 + cg4 + i) * zf; xc[i] += cw[0] * xv[i]; xc[i + 1] += cw[1] * xv[i + 1]; xc[i + 2] += cw[2] * xv[i + 2]; xc[i + 3] += cw[3] * xv[i + 3]; } }
            if (j + ns < 256) RNN_LOAD(j + ns);
#pragma unroll
            for (int i = 0; i < 16; ++i) xcf[tok * 65 + cg4 + i] = xc[i];
            u32x4 o0 = {cvtpk(xc[0], xc[1]), cvtpk(xc[2], xc[3]), cvtpk(xc[4], xc[5]), cvtpk(xc[6], xc[7])}, o1 = {cvtpk(xc[8], xc[9]), cvtpk(xc[10], xc[11]), cvtpk(xc[12], xc[13]), cvtpk(xc[14], xc[15])};
            *(u32x4*)(xcb + tok * 72 + cg4) = o0; *(u32x4*)(xcb + tok * 72 + cg4 + 8) = o1;
        }
        LBAR();
        {
            const bf16x8 a0 = *(const bf16x8*)(xcb + (wave * 16 + l16) * 72 + q4 * 8), a1 = *(const bf16x8*)(xcb + (wave * 16 + l16) * 72 + 32 + q4 * 8);
#pragma unroll
            for (int cg = 0; cg < 4; ++cg) { const int ch = cg * 16 + l16;
                f32x4 ca = {0.f, 0.f, 0.f, 0.f}, cx = {0.f, 0.f, 0.f, 0.f};
                const bf16x8 wa0 = *(const bf16x8*)(WtL + ch * 72 + q4 * 8), wa1 = *(const bf16x8*)(WtL + ch * 72 + 32 + q4 * 8);
                const bf16x8 wx0 = *(const bf16x8*)(WtL + (64 + ch) * 72 + q4 * 8), wx1 = *(const bf16x8*)(WtL + (64 + ch) * 72 + 32 + q4 * 8);
                ca = __builtin_amdgcn_mfma_f32_16x16x32_bf16(a0, wa0, ca, 0, 0, 0); ca = __builtin_amdgcn_mfma_f32_16x16x32_bf16(a1, wa1, ca, 0, 0, 0);
                cx = __builtin_amdgcn_mfma_f32_16x16x32_bf16(a0, wx0, cx, 0, 0, 0); cx = __builtin_amdgcn_mfma_f32_16x16x32_bf16(a1, wx1, cx, 0, 0, 0);
#pragma unroll
                for (int i = 0; i < 4; ++i) { const int tk = wave * 16 + q4 * 4 + i; const float xv = xcf[tk * 65 + ch];
                    const float r = sigmoidf_(ca[i] + bav[cg]), ig = sigmoidf_(cx[i] + bxv[cg]), la = -r * sp8[cg], a = __expf(la);
                    const float y2 = 2.f * la; const float om = y2 < -0.05f ? 1.f - a * a : -y2 * (1.f + y2 * (0.5f + y2 * (0.16666667f + y2 * 0.041666668f)));
                    const float u = __builtin_amdgcn_sqrtf(fmaxf(om, 0.f)) * (ig * xv);
                    aL[tk * 65 + ch] = a; uL[tk * 65 + ch] = u; } }
        }
        LBAR();
        {
            float h = 0.f, P = 1.f;
#pragma unroll
            for (int i = 0; i < 16; ++i) { const int o = (wave * 16 + i) * 65 + lane; const float a = aL[o], u = uL[o]; h = a * h + u; P *= a; uL[o] = h; aL[o] = P; }
            segA[wave * 64 + lane] = P; segH[wave * 64 + lane] = h;
        }
        LBAR();
        {
            float Ain = 1.f, Hin = 0.f;
            for (int s = 0; s < wave; ++s) { const float As = segA[s * 64 + lane], Hs = segH[s * 64 + lane]; Hin = As * Hin + Hs; Ain *= As; }
            const size_t gbase = ((size_t)b * SEQ + t0 + wave * 16) * DM + ch0 + lane;
            float hl = 0.f, pc = 0.f;
#pragma unroll
            for (int i = 0; i < 16; ++i) { const int o = (wave * 16 + i) * 65 + lane; hl = uL[o] + aL[o] * Hin; pc = aL[o] * Ain;
                hloc[gbase + (size_t)i * DM] = (bf16_t)(cvtpk(hl, hl) & 0xffffu); pcum[gbase + (size_t)i * DM] = (bf16_t)(cvtpk(pc, pc) & 0xffffu); }
            if (wave == 7) { const size_t ao = ((size_t)b * 128 + chunk) * 1024 + ch0 + lane; aggA[ao] = pc; aggH[ao] = hl; }
        }
    }
#undef RNN_LOAD
#undef LBAR
    __syncthreads();
}
DEVI void rnn_carry_phase(const float* aggA, const float* aggH, float* carry, int wv) {
    const int g = lbid() * 512 + ltid(wv);
    if (g < 2048) { const int b = g >> 10, ch = g & 1023; float H = 0.f;
        for (int c0 = 0; c0 < 128; c0 += 64) { float A[64], Hh[64];
#pragma unroll
            for (int i = 0; i < 64; ++i) { const size_t o = ((size_t)b * 128 + c0 + i) * 1024 + ch; A[i] = aggA[o]; Hh[i] = aggH[o]; }
#pragma unroll
            for (int i = 0; i < 64; ++i) { carry[((size_t)b * 128 + c0 + i) * 1024 + ch] = H; H = A[i] * H + Hh[i]; } } }
}
DEVI void rnn_fix_phase(const bf16_t* hloc, const bf16_t* pcum, const float* carry, bf16_t* gr_yr, int wv) {
    const size_t nvec = (size_t)T_TOK * DM / 8, stride = (size_t)lgrid() * 512;
    for (size_t idx0 = (size_t)lbid() * 512 + ltid(wv); idx0 < nvec; idx0 += 2 * stride) {
        u32x4 hw[2], pw[2], gw[2]; f32x4 c0[2], c1[2];
#pragma unroll
        for (int q = 0; q < 2; ++q) { const size_t idx = idx0 + q * stride; if (idx >= nvec) break; const size_t row = idx >> 7; const int c8 = (int)(idx & 127) * 8; const int b = (int)(row >> 14), chunk = (int)((row & 16383) >> 7);
            hw[q] = *(const u32x4*)(hloc + idx * 8); pw[q] = *(const u32x4*)(pcum + idx * 8); gw[q] = *(const u32x4*)(gr_yr + idx * 8);
            const float* cp = carry + ((size_t)b * 128 + chunk) * 1024 + c8; c0[q] = *(const f32x4*)cp; c1[q] = *(const f32x4*)(cp + 4); }
#pragma unroll
        for (int q = 0; q < 2; ++q) { const size_t idx = idx0 + q * stride; if (idx >= nvec) break;
            const float hv[8] = {bflo(hw[q].x), bfhi(hw[q].x), bflo(hw[q].y), bfhi(hw[q].y), bflo(hw[q].z), bfhi(hw[q].z), bflo(hw[q].w), bfhi(hw[q].w)};
            const float pv[8] = {bflo(pw[q].x), bfhi(pw[q].x), bflo(pw[q].y), bfhi(pw[q].y), bflo(pw[q].z), bfhi(pw[q].z), bflo(pw[q].w), bfhi(pw[q].w)};
            const float gv[8] = {bflo(gw[q].x), bfhi(gw[q].x), bflo(gw[q].y), bfhi(gw[q].y), bflo(gw[q].z), bfhi(gw[q].z), bflo(gw[q].w), bfhi(gw[q].w)};
            const float cv[8] = {c0[q][0], c0[q][1], c0[q][2], c0[q][3], c1[q][0], c1[q][1], c1[q][2], c1[q][3]};
            float y[8];
#pragma unroll
            for (int i = 0; i < 8; ++i) { const float x = gv[i], z = 1.5957691216f * (x + 0.044715f * x * x * x); y[i] = (hv[i] + pv[i] * cv[i]) * x * sigmoidf_(z); }
            u32x4 o = {cvtpk(y[0], y[1]), cvtpk(y[2], y[3]), cvtpk(y[4], y[5]), cvtpk(y[6], y[7])};
            *(u32x4*)(gr_yr + idx * 8) = o; }
    }
}

struct Args { const float* in[24]; float* out; unsigned char* ws; int ph_lo, ph_hi; };
enum { I_X = 0, I_F1N, I_F1G, I_F1U, I_F1D, I_MIXN, I_WIN, I_BIN, I_QN, I_KN, I_CW, I_CB, I_LWA, I_LBA, I_LWX, I_LBX, I_LAM, I_WOA, I_WOR, I_WOUT, I_F2N, I_F2G, I_F2U, I_F2D };

__global__ void __launch_bounds__(512, 2) fwd_mega(Args a) {
    extern __shared__ __attribute__((aligned(16))) unsigned char lds[];
    cg::grid_group grid = cg::this_grid();
    char* ldc = (char*)lds; PG8_LAS unsigned char* ldl = (PG8_LAS unsigned char*)lds;
    const int wv = __builtin_amdgcn_readfirstlane((int)(threadIdx.x >> 6));
    if (threadIdx.x < 4) ((LAS unsigned*)(lds + LDS_BAR))[threadIdx.x] = 0u;
    __syncthreads();
    (void)xcd_barrier_post((unsigned*)(a.ws + WS_BAR), (volatile LAS unsigned*)(lds + LDS_BAR), wv);
#define GBAR() do { XcdBarrier xb_; xb_.bar = (unsigned*)(ws + WS_BAR); xb_.x = xb_xcc_id(); xb_.st = (volatile LAS unsigned*)(lds + LDS_BAR); xcd_barrier(xb_, wv); } while (0)
    for (int ph = a.ph_lo; ph < a.ph_hi; ++ph) {
        const int G = lgrid(), bid = lbid();
        int zi = 0; asm volatile("" : "+s"(zi));
#define IN(i) a.in[(i) + zi]
        unsigned char* ws = a.ws; float* xo = a.out;
        asm volatile("" : "+s"(ws), "+s"(xo));
        bf16_t* U0 = (bf16_t*)ws; bf16_t* U1 = (bf16_t*)(ws + UNIT); bf16_t* U2 = (bf16_t*)(ws + 2 * UNIT); bf16_t* U3 = (bf16_t*)(ws + 3 * UNIT);
        bf16_t* U4 = (bf16_t*)(ws + 4 * UNIT); bf16_t* U5 = (bf16_t*)(ws + 5 * UNIT); bf16_t* U6 = (bf16_t*)(ws + 6 * UNIT); bf16_t* U7 = (bf16_t*)(ws + 7 * UNIT);
        const int l = ph >> 4, p = ph & 15;
        if (p == 5 || p == 11) continue;
        const size_t oF = (size_t)l * DM * DFF;
#ifdef ONLY
        if (p != ONLY) continue;
#endif
        for (int rep = 0; rep < (((REPEAT_MASK >> p) & 1) ? 2 : 1); ++rep) {
        if (rep) GBAR();
        switch (p) {
        case 0: {
            cvt_ffn_phase(IN(I_F1G) + oF, IN(I_F1U) + oF, IN(I_F1D) + oF, ws, ldc, bid, G, wv);
            norm_phase(l == 0 ? IN(I_X) : xo, IN(I_F1N) + l * DM, U0, nullptr, nullptr, nullptr, ldc, wv);
        } break;
        case 13:
            norm_phase(xo, IN(I_F2N) + l * DM, U0, nullptr, nullptr, nullptr, ldc, wv);
            break;
        case 1: case 14: {
            pg8::Gemm g{U0, (const bf16_t*)(ws + FFW_GU), T_TOK, 2 * DFF, DM, nullptr, DM}; pg8::StaticOrder S; S.init(T_TOK, 2 * DFF, G, bid);
            EpiUp E{U1}; pg8::gemm_phase(ldl, g, S, E, wv);
        } break;
        case 2: case 15: {
            pg8::Gemm g{U1, (const bf16_t*)(ws + FFW_D), T_TOK, DM, DFF, nullptr, DFF}; pg8::StaticOrder S; S.init(T_TOK, DM, G, bid);
            EpiRes E{(l == 0 && p == 2) ? IN(I_X) : xo, xo, 0.5f}; pg8::gemm_phase(ldl, g, S, E, wv);
        } break;
        case 3: {
            cvt_mix_phase(IN(I_WIN) + (size_t)l * DM * NIN, IN(I_WOA) + (size_t)l * DM * DM, IN(I_WOR) + (size_t)l * DM * DM, IN(I_WOUT) + (size_t)l * DM * DM,
                          IN(I_LWA) + (size_t)l * 65536, IN(I_LWX) + (size_t)l * 65536, ws, ldc, wv);
            norm_phase(xo, IN(I_MIXN) + l * DM, U0, IN(I_WIN) + (size_t)l * DM * NIN, IN(I_BIN) + (size_t)l * NIN + 3072, (float*)(ws + WS_LOGF), ldc, wv);
        } break;
        case 4: {
            post_inproj_phase((const float*)(ws + WS_LOGF), (float*)(ws + WS_CS), (int*)(ws + WS_JLO), IN(I_QN) + l * 128, IN(I_KN) + l * 128, U1, U2, ldc, wv);
            pg8::Gemm g{U0, (const bf16_t*)(ws + WS_WIN), T_TOK, NINP, DM, nullptr, DM}; pg8::StaticOrder S; S.init(T_TOK, NINP, G, bid);
            EpiInProj E{ws, IN(I_BIN) + (size_t)l * NIN, IN(I_QN) + l * 128, IN(I_KN) + l * 128, (float*)(ldc + 131072)}; pg8::gemm_phase(ldl, g, S, E, wv);
        } break;
        case 6:
            att::phase(U1, U2, U3, U0, (const float*)(ws + WS_CS), (const int*)(ws + WS_JLO), ldc, wv);
            break;
        case 7:
            rnn_local_phase(U4, IN(I_CW) + l * 4096, IN(I_CB) + l * 1024, (const bf16_t*)(ws + WS_LRU), IN(I_LBA) + l * 1024, IN(I_LBX) + l * 1024, IN(I_LAM) + l * 1024,
                            U2, U3, (float*)(ws + WS_AGGA), (float*)(ws + WS_AGGH), ldc, wv);
            break;
        case 8:
            if (bid < 4 || G < 8) rnn_carry_phase((const float*)(ws + WS_AGGA), (const float*)(ws + WS_AGGH), (float*)(ws + WS_CARRY), wv);
            if (G < 8) cvt_ffn_phase(IN(I_F2G) + oF, IN(I_F2U) + oF, IN(I_F2D) + oF, ws, ldc, bid, G, wv);
            else if (bid >= 4) cvt_ffn_phase(IN(I_F2G) + oF, IN(I_F2U) + oF, IN(I_F2D) + oF, ws, ldc, bid - 4, G - 4, wv);
            break;
        case 9:
            rnn_fix_phase(U2, U3, (const float*)(ws + WS_CARRY), U5, wv);
            break;
        case 10: {
            pg8::Gemm g{U0, (const bf16_t*)(ws + WS_WOA), T_TOK, DM, 2 * DM, U5, DM}; pg8::StaticOrder S; S.init(T_TOK, DM, G, bid);
            EpiMergeF E{U6, U7, U2}; pg8::gemm_phase(ldl, g, S, E, wv);
        } break;
        case 12: {
            pg8::Gemm g{U2, (const bf16_t*)(ws + WS_WOUT), T_TOK, DM, DM, nullptr, DM}; pg8::StaticOrder S; S.init(T_TOK, DM, G, bid);
            EpiRes E{xo, xo, 1.0f}; pg8::gemm_phase(ldl, g, S, E, wv);
        } break;
        }
        }
        if (ph + 1 < a.ph_hi) { if (ph == a.ph_lo) grid.sync(); else for (int sr_ = 0; sr_ < SYNC_REPS; ++sr_) GBAR(); }
    }
}

extern "C" void kernel_launch(void* const* d_in, const int* in_sizes, int n_in, void* d_out, int out_size, void* d_ws, size_t ws_size, hipStream_t stream) {
    static int grid_blocks = 0;
    if (grid_blocks == 0) {
        if (n_in != 24 || ws_size < WS_END) { fprintf(stderr, "kernel_launch: unexpected n_in %d / ws_size %zu (need %zu)\n", n_in, ws_size, (size_t)WS_END); grid_blocks = -1; return; }
        int dev = 0, cus = 0, per_cu = 0;
        (void)hipGetDevice(&dev); (void)hipDeviceGetAttribute(&cus, hipDeviceAttributeMultiprocessorCount, dev);
        if (hipFuncSetAttribute((const void*)fwd_mega, hipFuncAttributeMaxDynamicSharedMemorySize, LDS_BYTES) != hipSuccess) { fprintf(stderr, "kernel_launch: hipFuncSetAttribute failed\n"); grid_blocks = -1; return; }
        if (hipOccupancyMaxActiveBlocksPerMultiprocessor(&per_cu, (const void*)fwd_mega, 512, LDS_BYTES) != hipSuccess || per_cu < 1) { fprintf(stderr, "kernel_launch: occupancy query gave %d\n", per_cu); per_cu = 1; }
        (void)hipGetLastError();
        grid_blocks = cus;
        fprintf(stderr, "kernel_launch: grid %d (per_cu %d), ws %zu need %zu\n", grid_blocks, per_cu, ws_size, (size_t)WS_END);
    }
    if (grid_blocks < 0) return;
    (void)hipMemsetAsync((char*)d_ws + WS_BAR, 0, 16384, stream);
    Args a{};
    for (int i = 0; i < 24; ++i) a.in[i] = (const float*)d_in[i];
    a.out = (float*)d_out; a.ws = (unsigned char*)d_ws; a.ph_lo = 0; a.ph_hi = DEPTH * 16;
    void* args[] = {&a};
    hipError_t e = hipLaunchCooperativeKernel((const void*)fwd_mega, dim3(grid_blocks), dim3(512), args, LDS_BYTES, stream);
    if (e != hipSuccess) fprintf(stderr, "cooperative launch failed: %s (grid %d)\n", hipGetErrorString(e), grid_blocks);
}
```
